# Optimizing an MI355X kernel written in HIP

```python
import jax, jax.numpy as jnp
from jax import lax
import numpy as np

D_MODEL = 2048
BATCH = 4
SEQ = 4096
DEPTH = 2

GRID_W = 64
CTX_LEN = 256

SWA_HEADS = 6
SWA_KV_HEADS = 2
SWA_HEAD_DIM = 128
SWA_WINDOW = 128
SWA_BLOCK = 128
RET_HEADS = 6
RET_QK_DIM = 64
RET_V_DIM = 128
RET_CHUNK = 128
RET_DECAY_BASE = 5.0
MLA_HEADS = 4
MLA_NOPE_DIM = 128
MLA_ROPE_DIM = 64
MLA_V_DIM = 128
MLA_KV_RANK = 256
MLA_Q_BLOCK = 128

SWA_WIDTH = SWA_HEADS * SWA_HEAD_DIM
RET_WIDTH = RET_HEADS * RET_V_DIM
MLA_WIDTH = MLA_HEADS * MLA_V_DIM
MIX_WIDTH = SWA_WIDTH + RET_WIDTH + MLA_WIDTH

IN_SPLITS = (SWA_HEADS * SWA_HEAD_DIM, SWA_KV_HEADS * SWA_HEAD_DIM, SWA_KV_HEADS * SWA_HEAD_DIM,
             RET_HEADS * RET_QK_DIM, RET_HEADS * RET_QK_DIM, RET_WIDTH, RET_WIDTH, RET_WIDTH,
             MLA_HEADS * (MLA_NOPE_DIM + MLA_ROPE_DIM), MLA_KV_RANK, MLA_ROPE_DIM)
IN_WIDTH = sum(IN_SPLITS)

N_GROUPS = 4
EXPERTS_PER_GROUP = 8
N_EXPERTS = N_GROUPS * EXPERTS_PER_GROUP
TOP_K = 2
EXPERT_HIDDEN = 1024
MOE_BLOCK = 128

ALPHA = (2 * DEPTH) ** 0.25
BETA = (8 * DEPTH) ** -0.25
ROPE_BASE = 10000.0
NORM_EPS = 1e-6
NEG_INF = -1e30

kernel_name = 'hybrid_dit_swa_retnet_mla_hmoe'


def layer_norm(x, eps=NORM_EPS):
    xf = x.astype(jnp.float32)
    mu = jnp.mean(xf, axis=-1, keepdims=True)
    xc = xf - mu
    var = jnp.mean(xc * xc, axis=-1, keepdims=True)
    return (xc * lax.rsqrt(var + eps)).astype(x.dtype)


def affine_layer_norm(x, g, b):
    return layer_norm(x) * g + b


def rms_norm(x, g, eps=NORM_EPS):
    xf = x.astype(jnp.float32)
    y = xf * lax.rsqrt(jnp.mean(xf * xf, axis=-1, keepdims=True) + eps)
    return y.astype(x.dtype) * g


def modulate(x, shift, scale):
    return layer_norm(x) * (1.0 + scale) + shift


def rope_1d(x, pos):
    half = x.shape[-1] // 2
    inv_freq = ROPE_BASE ** (-jnp.arange(half, dtype=jnp.float32) / half)
    ang = pos.astype(jnp.float32)[:, None] * inv_freq[None, :]
    cos = jnp.cos(ang)[:, None, :].astype(x.dtype)
    sin = jnp.sin(ang)[:, None, :].astype(x.dtype)
    x1, x2 = x[..., :half], x[..., half:]
    return jnp.concatenate([x1 * cos - x2 * sin, x2 * cos + x1 * sin], axis=-1)


def rope_2d(x, rows, cols):
    d = x.shape[-1] // 2
    return jnp.concatenate([rope_1d(x[..., :d], rows), rope_1d(x[..., d:], cols)], axis=-1)


def split_projection(t):
    pts, acc = [], 0
    for s in IN_SPLITS[:-1]:
        acc += s
        pts.append(acc)
    return jnp.split(t, pts, axis=-1)


def swa_mixer(q, k, v, qc, kc, vc, sink, rows, cols, compute_ctx):
    B, L = q.shape[0], q.shape[1]
    n_ctx = kc.shape[1]
    nb = L // SWA_BLOCK
    G = SWA_HEADS // SWA_KV_HEADS
    scale = SWA_HEAD_DIM ** -0.5
    qb = rope_2d(q, rows, cols).reshape(B, nb, SWA_BLOCK, SWA_KV_HEADS, G, SWA_HEAD_DIM)
    k = rope_2d(k, rows, cols)

    def band(t):
        pad = jnp.zeros((B, SWA_BLOCK) + t.shape[2:], t.dtype)
        tb = jnp.concatenate([pad, t, pad], axis=1).reshape((B, nb + 2, SWA_BLOCK) + t.shape[2:])
        return jnp.concatenate([tb[:, :-2], tb[:, 1:-1], tb[:, 2:]], axis=2)

    kw, vw = band(k), band(v)
    q_pos = jnp.arange(nb)[:, None] * SWA_BLOCK + jnp.arange(SWA_BLOCK)[None, :]
    k_pos = jnp.arange(nb)[:, None] * SWA_BLOCK - SWA_BLOCK + jnp.arange(3 * SWA_BLOCK)[None, :]
    valid = ((jnp.abs(q_pos[:, :, None] - k_pos[:, None, :]) <= SWA_WINDOW)
             & (k_pos >= 0)[:, None, :] & (k_pos < L)[:, None, :])
    s_loc = jnp.einsum('bnqhgd,bnkhd->bnhgqk', qb, kw).astype(jnp.float32) * scale
    s_loc = jnp.where(valid[None, :, None, None], s_loc, NEG_INF)
    s_ctx = jnp.einsum('bnqhgd,bkhd->bnhgqk', qb, kc).astype(jnp.float32) * scale
    sink_f = sink.astype(jnp.float32)
    sink_l = jnp.broadcast_to(sink_f.reshape(1, 1, SWA_KV_HEADS, G, 1, 1), s_loc.shape[:-1] + (1,))
    p = jax.nn.softmax(jnp.concatenate([sink_l, s_ctx, s_loc], axis=-1), axis=-1).astype(v.dtype)
    out = (jnp.einsum('bnhgqk,bkhd->bnqhgd', p[..., 1:1 + n_ctx], vc)
           + jnp.einsum('bnhgqk,bnkhd->bnqhgd', p[..., 1 + n_ctx:], vw)).reshape(B, L, SWA_WIDTH)
    out_c = None
    if compute_ctx:
        qcg = qc.reshape(B, n_ctx, SWA_KV_HEADS, G, SWA_HEAD_DIM)
        s = jnp.einsum('bqhgd,bkhd->bhgqk', qcg, kc).astype(jnp.float32) * scale
        sink_c = jnp.broadcast_to(sink_f.reshape(1, SWA_KV_HEADS, G, 1, 1), s.shape[:-1] + (1,))
        pc = jax.nn.softmax(jnp.concatenate([sink_c, s], axis=-1), axis=-1).astype(vc.dtype)
        out_c = jnp.einsum('bhgqk,bkhd->bqhgd', pc[..., 1:], vc).reshape(B, n_ctx, SWA_WIDTH)
    return out, out_c


def retention_chunks(q, k, v, log_gamma, s0):
    B, H, T, dk = q.shape
    dv = v.shape[-1]
    C = RET_CHUNK
    n = T // C
    qc = q.reshape(B, H, n, C, dk)
    kc = k.reshape(B, H, n, C, dk)
    vc = v.reshape(B, H, n, C, dv)
    idx = jnp.arange(C, dtype=jnp.float32)
    diff = idx[:, None] - idx[None, :]
    dmat = jnp.where(diff >= 0, jnp.exp(log_gamma[:, None, None] * jnp.maximum(diff, 0.0)), 0.0)
    q_decay = jnp.exp(log_gamma[:, None] * (idx + 1.0))
    k_decay = jnp.exp(log_gamma[:, None] * (C - 1.0 - idx))
    c_decay = jnp.exp(log_gamma * C)
    scores = jnp.einsum('bhncd,bhnsd->bhncs', qc, kc) * dmat[None, :, None]
    y = jnp.einsum('bhncs,bhnse->bhnce', scores, vc)
    kv = jnp.einsum('bhnsd,bhnse->nbhde', kc * k_decay[None, :, None, :, None], vc)

    def step(s, kv_i):
        return c_decay[None, :, None, None] * s + kv_i, s

    s_last, s_prev = lax.scan(step, s0, kv)
    y = y + jnp.einsum('bhncd,nbhde->bhnce', qc * q_decay[None, :, None, :, None], s_prev)
    return y.reshape(B, H, T, dv), s_last


def retention_mixer(q, k, v, gf, gb, qc, kc, vc, gfc, gbc, decay_exp, compute_ctx):
    B, L = q.shape[0], q.shape[1]
    n_ctx = qc.shape[1]
    pos_c = jnp.arange(n_ctx, dtype=jnp.float32)
    pos_l = n_ctx + jnp.arange(L, dtype=jnp.float32)
    qk_scale = RET_QK_DIM ** -0.5

    def heads(t):
        return jnp.transpose(t, (0, 2, 1, 3)).astype(jnp.float32)

    q_l, k_l, v_l = heads(rope_1d(q, pos_l) * qk_scale), heads(rope_1d(k, pos_l)), heads(v)
    q_c, k_c, v_c = heads(rope_1d(qc, pos_c) * qk_scale), heads(rope_1d(kc, pos_c)), heads(vc)
    log_gamma = jnp.log1p(-jnp.exp2(-decay_exp.astype(jnp.float32)))
    s0 = jnp.zeros((B, RET_HEADS, RET_QK_DIM, RET_V_DIM), jnp.float32)

    def rev(t):
        return jnp.flip(t, axis=2)

    yc_f, sc_f = retention_chunks(q_c, k_c, v_c, log_gamma[0], s0)
    yc_b, sc_b = retention_chunks(rev(q_c), rev(k_c), rev(v_c), log_gamma[1], s0)
    y_f, _ = retention_chunks(q_l, k_l, v_l, log_gamma[0], sc_f)
    y_b, _ = retention_chunks(rev(q_l), rev(k_l), rev(v_l), log_gamma[1], sc_b)

    def merge(yf, yb, g_f, g_b):
        def norm(y):
            yn = layer_norm(y)
            return jnp.transpose(yn, (0, 2, 1, 3)).reshape(B, -1, RET_WIDTH).astype(g_f.dtype)
        return jax.nn.silu(g_f) * norm(yf) + jax.nn.silu(g_b) * norm(yb)

    out = merge(y_f, rev(y_b), gf, gb)
    out_c = merge(yc_f, rev(yc_b), gfc, gbc) if compute_ctx else None
    return out, out_c


def mla_mixer(q, ckv, k_rope, qc, ckv_c, k_rope_c, kv_norm_g, w_uk, w_uv, rows, cols, compute_ctx):
    B, L = q.shape[0], q.shape[1]
    n_ctx = qc.shape[1]
    scale = (MLA_NOPE_DIM + MLA_ROPE_DIM) ** -0.5
    w_uk = w_uk.reshape(MLA_KV_RANK, MLA_HEADS, MLA_NOPE_DIM)
    w_uv = w_uv.reshape(MLA_KV_RANK, MLA_HEADS, MLA_V_DIM)

    def expand(c):
        c = rms_norm(c, kv_norm_g)
        return jnp.einsum('btr,rhd->bthd', c, w_uk), jnp.einsum('btr,rhd->bthd', c, w_uv)

    k_nope, v = expand(ckv)
    kc_nope, vc = expand(ckv_c)
    k_rope = rope_2d(k_rope[:, :, None, :], rows, cols)[:, :, 0]
    q_nope = q[..., :MLA_NOPE_DIM]
    q_rope = rope_2d(q[..., MLA_NOPE_DIM:], rows, cols)
    nb = L // MLA_Q_BLOCK

    def to_blocks(t):
        return jnp.moveaxis(t.reshape((B, nb, MLA_Q_BLOCK) + t.shape[2:]), 1, 0)

    def attend(args):
        qn, qr = args
        s_c = jnp.einsum('bqhd,bkhd->bhqk', qn, kc_nope) + jnp.einsum('bqhd,bkd->bhqk', qr, k_rope_c)
        s_l = jnp.einsum('bqhd,bkhd->bhqk', qn, k_nope) + jnp.einsum('bqhd,bkd->bhqk', qr, k_rope)
        p = jax.nn.softmax(jnp.concatenate([s_c, s_l], axis=-1).astype(jnp.float32) * scale, axis=-1).astype(v.dtype)
        return jnp.einsum('bhqk,bkhd->bqhd', p[..., :n_ctx], vc) + jnp.einsum('bhqk,bkhd->bqhd', p[..., n_ctx:], v)

    out = lax.map(attend, (to_blocks(q_nope), to_blocks(q_rope)))
    out = jnp.moveaxis(out, 0, 1).reshape(B, L, MLA_WIDTH)
    out_c = None
    if compute_ctx:
        s = (jnp.einsum('bqhd,bkhd->bhqk', qc[..., :MLA_NOPE_DIM], kc_nope)
             + jnp.einsum('bqhd,bkd->bhqk', qc[..., MLA_NOPE_DIM:], k_rope_c))
        pc = jax.nn.softmax(s.astype(jnp.float32) * scale, axis=-1).astype(vc.dtype)
        out_c = jnp.einsum('bhqk,bkhd->bqhd', pc, vc).reshape(B, n_ctx, MLA_WIDTH)
    return out, out_c


def token_mixer(h, hc, w_in, w_out, swa_sink, ret_decay, mla_kv_norm, mla_w_uk, mla_w_uv, rows, cols, compute_ctx):
    B, L, _ = h.shape
    n_ctx = hc.shape[1]

    def hd(t, n):
        return t.reshape(t.shape[0], t.shape[1], n, -1)

    sq, sk, sv, rq, rk, rv, rgf, rgb, mq, mckv, mkr = split_projection(h @ w_in)
    csq, csk, csv, crq, crk, crv, crgf, crgb, cmq, cmckv, cmkr = split_projection(hc @ w_in)
    a, a_c = swa_mixer(hd(sq, SWA_HEADS), hd(sk, SWA_KV_HEADS), hd(sv, SWA_KV_HEADS),
                       hd(csq, SWA_HEADS), hd(csk, SWA_KV_HEADS), hd(csv, SWA_KV_HEADS),
                       swa_sink, rows, cols, compute_ctx)
    r, r_c = retention_mixer(hd(rq, RET_HEADS), hd(rk, RET_HEADS), hd(rv, RET_HEADS), rgf, rgb,
                             hd(crq, RET_HEADS), hd(crk, RET_HEADS), hd(crv, RET_HEADS), crgf, crgb,
                             ret_decay, compute_ctx)
    m, m_c = mla_mixer(hd(mq, MLA_HEADS), mckv, mkr, hd(cmq, MLA_HEADS), cmckv, cmkr,
                       mla_kv_norm, mla_w_uk, mla_w_uv, rows, cols, compute_ctx)
    y = jnp.concatenate([a, r, m], axis=-1) @ w_out
    y_c = jnp.concatenate([a_c, r_c, m_c], axis=-1) @ w_out if compute_ctx else None
    return y, y_c


def routed_experts(h, expert_id, weight, w_gate, w_up, w_down):
    N, D = h.shape
    A = expert_id.shape[0]
    n_blocks = (A + MOE_BLOCK - 1) // MOE_BLOCK + N_EXPERTS
    rows_total = n_blocks * MOE_BLOCK
    tok = jnp.arange(A, dtype=jnp.int32) // TOP_K
    order = jnp.argsort(expert_id)
    e_sorted = expert_id[order]
    counts = jnp.bincount(expert_id, length=N_EXPERTS)
    starts = jnp.cumsum(counts) - counts
    padded = (counts + MOE_BLOCK - 1) // MOE_BLOCK * MOE_BLOCK
    ends = jnp.cumsum(padded)
    pstarts = ends - padded
    dest = pstarts[e_sorted] + jnp.arange(A, dtype=jnp.int32) - starts[e_sorted]
    buf_tok = jnp.full((rows_total,), N, jnp.int32).at[dest].set(tok[order])
    buf_w = jnp.zeros((rows_total,), jnp.float32).at[dest].set(weight[order].astype(jnp.float32))
    block_expert = jnp.minimum(jnp.searchsorted(ends, jnp.arange(n_blocks, dtype=jnp.int32) * MOE_BLOCK, side='right'),
                               N_EXPERTS - 1)
    h_pad = jnp.concatenate([h, jnp.zeros((1, D), h.dtype)], axis=0)

    def expert_block(args):
        tok_blk, e = args
        xb = h_pad[tok_blk]
        return (jax.nn.silu(xb @ w_gate[e]) * (xb @ w_up[e])) @ w_down[e]

    yb = lax.map(expert_block, (buf_tok.reshape(n_blocks, MOE_BLOCK), block_expert)).reshape(rows_total, D)
    yb = yb * buf_w[:, None].astype(yb.dtype)
    return jax.ops.segment_sum(yb, buf_tok, num_segments=N + 1)[:N]


def hier_moe(h, w_group, b_group, w_expert, b_expert, w_gate, w_up, w_down):
    N = h.shape[0]
    g_logits = (h @ w_group).astype(jnp.float32) + b_group.astype(jnp.float32)
    g_prob = jax.nn.softmax(g_logits, axis=-1)
    g_idx = jnp.argmax(g_logits, axis=-1)
    rows = jnp.arange(N)
    p_group = g_prob[rows, g_idx][:, None]
    e_logits = ((h @ w_expert).astype(jnp.float32) + b_expert.astype(jnp.float32)).reshape(N, N_GROUPS, EXPERTS_PER_GROUP)
    e_in = e_logits[rows, g_idx]
    e_top, e_idx = lax.top_k(e_in, TOP_K)
    gate = jax.nn.softmax(e_top, axis=-1) * p_group
    expert_id = (g_idx[:, None] * EXPERTS_PER_GROUP + e_idx).astype(jnp.int32).reshape(-1)
    return routed_experts(h, expert_id, gate.reshape(-1), w_gate, w_up, w_down)


def setup_inputs(seed: int = 0) -> dict:
    key = jax.random.key(seed)
    ks = jax.random.split(key, 26)
    f32 = jnp.float32
    Dm = D_MODEL

    def nrm(k, shape, scale):
        return jax.random.normal(k, shape, f32) * scale

    return {
        'x': nrm(ks[0], (BATCH, SEQ, Dm), 1.0),
        'c': nrm(ks[1], (BATCH, Dm), 1.0),
        'ctx': nrm(ks[2], (BATCH, CTX_LEN, Dm), 1.0),
        'c_ctx': nrm(ks[3], (Dm,), 1.0),
        'w_ada': nrm(ks[4], (DEPTH, Dm, 6 * Dm), Dm ** -0.5),
        'b_ada': nrm(ks[5], (DEPTH, 6 * Dm), 0.02),
        'w_in': nrm(ks[6], (DEPTH, Dm, IN_WIDTH), Dm ** -0.5),
        'swa_sink': nrm(ks[7], (DEPTH, SWA_HEADS), 0.5),
        'ret_decay': RET_DECAY_BASE + jnp.arange(RET_HEADS, dtype=f32) + nrm(ks[8], (DEPTH, 2, RET_HEADS), 0.1),
        'mla_kv_norm': 1.0 + nrm(ks[9], (DEPTH, MLA_KV_RANK), 0.02),
        'mla_w_uk': nrm(ks[10], (DEPTH, MLA_KV_RANK, MLA_HEADS * MLA_NOPE_DIM), MLA_KV_RANK ** -0.5),
        'mla_w_uv': nrm(ks[11], (DEPTH, MLA_KV_RANK, MLA_HEADS * MLA_V_DIM), MLA_KV_RANK ** -0.5),
        'w_out': nrm(ks[12], (DEPTH, MIX_WIDTH, Dm), BETA * MIX_WIDTH ** -0.5),
        'ln1_g': 1.0 + nrm(ks[13], (DEPTH, Dm), 0.02),
        'ln1_b': nrm(ks[14], (DEPTH, Dm), 0.02),
        'ln2_g': 1.0 + nrm(ks[15], (DEPTH, Dm), 0.02),
        'ln2_b': nrm(ks[16], (DEPTH, Dm), 0.02),
        'moe_w_group': nrm(ks[17], (DEPTH, Dm, N_GROUPS), Dm ** -0.5),
        'moe_b_group': nrm(ks[18], (DEPTH, N_GROUPS), 0.01),
        'moe_w_expert': nrm(ks[19], (DEPTH, Dm, N_EXPERTS), Dm ** -0.5),
        'moe_b_expert': nrm(ks[20], (DEPTH, N_EXPERTS), 0.01),
        'moe_w_gate': nrm(ks[21], (DEPTH, N_EXPERTS, Dm, EXPERT_HIDDEN), Dm ** -0.5),
        'moe_w_up': nrm(ks[22], (DEPTH, N_EXPERTS, Dm, EXPERT_HIDDEN), Dm ** -0.5),
        'moe_w_down': nrm(ks[23], (DEPTH, N_EXPERTS, EXPERT_HIDDEN, Dm), BETA * EXPERT_HIDDEN ** -0.5),
    }


def reference(x, c, ctx, c_ctx, w_ada, b_ada, w_in, swa_sink, ret_decay, mla_kv_norm, mla_w_uk, mla_w_uv,
              w_out, ln1_g, ln1_b, ln2_g, ln2_b, moe_w_group, moe_b_group, moe_w_expert, moe_b_expert,
              moe_w_gate, moe_w_up, moe_w_down):
    B, L, D = x.shape
    n_rows = L // GRID_W
    rows = jnp.repeat(jnp.arange(n_rows, dtype=jnp.float32), GRID_W)
    cols = jnp.tile(jnp.arange(GRID_W, dtype=jnp.float32), n_rows)
    for l in range(DEPTH):
        ctx_out = l < DEPTH - 1
        mod = (jax.nn.silu(c) @ w_ada[l] + b_ada[l]).reshape(B, 6, D)
        mod_c = (jax.nn.silu(c_ctx) @ w_ada[l] + b_ada[l]).reshape(6, D)
        h = modulate(x, mod[:, 0, None], mod[:, 1, None])
        hc = modulate(ctx, mod_c[0], mod_c[1])
        y, y_c = token_mixer(h, hc, w_in[l], w_out[l], swa_sink[l], ret_decay[l], mla_kv_norm[l],
                             mla_w_uk[l], mla_w_uv[l], rows, cols, ctx_out)
        x = affine_layer_norm(ALPHA * x + mod[:, 2, None] * y, ln1_g[l], ln1_b[l])
        h = modulate(x, mod[:, 3, None], mod[:, 4, None]).reshape(B * L, D)
        if ctx_out:
            ctx = affine_layer_norm(ALPHA * ctx + mod_c[2] * y_c, ln1_g[l], ln1_b[l])
            hc = modulate(ctx, mod_c[3], mod_c[4]).reshape(-1, D)
            tokens = jnp.concatenate([h, hc], axis=0)
        else:
            tokens = h
        f = hier_moe(tokens, moe_w_group[l], moe_b_group[l], moe_w_expert[l], moe_b_expert[l],
                     moe_w_gate[l], moe_w_up[l], moe_w_down[l])
        x = affine_layer_norm(ALPHA * x + mod[:, 5, None] * f[:B * L].reshape(B, L, D), ln2_g[l], ln2_b[l])
        if ctx_out:
            ctx = affine_layer_norm(ALPHA * ctx + mod_c[5] * f[B * L:].reshape(B, -1, D), ln2_g[l], ln2_b[l])
    return x
```

```cpp
#include <hip/hip_runtime.h>
#include <stdint.h>
#include <stdio.h>
#include <string.h>

#ifndef MK_F8SEL
#define MK_F8SEL 2
#endif
#ifndef MK_OUT8
#define MK_OUT8 1
#endif
#ifndef MK_CONVPROBE
#define MK_CONVPROBE 0
#endif
#ifndef MK_PER_PHASE
#define MK_PER_PHASE 0
#endif

#ifndef MK_PHMASK
#define MK_PHMASK 0xFFFF
#endif
#define PHEN(k) (((MK_PHMASK) >> (k)) & 1)
#ifndef MK_DUP
#define MK_DUP 0
#endif
#define NREP(k) (1 + (((MK_DUP) >> (k)) & 1))
#define LAS __attribute__((address_space(3)))
typedef unsigned short bf16_t;
typedef short bf16x8 __attribute__((ext_vector_type(8)));
typedef short s16x4 __attribute__((ext_vector_type(4)));
typedef float f32x4 __attribute__((ext_vector_type(4)));
typedef float f32x16 __attribute__((ext_vector_type(16)));
typedef unsigned u32x4 __attribute__((ext_vector_type(4)));
typedef unsigned u32x2 __attribute__((ext_vector_type(2)));
typedef float f32x2 __attribute__((ext_vector_type(2)));

constexpr int D = 2048, NBATCH = 4, SEQ = 4096, NCTX = 256, TPB = SEQ + NCTX  ;
constexpr int NROWS = NBATCH * TPB;
constexpr int DEPTH = 2, INW = 5440, INWP = 5632, NEXP = 32, EH = 1024;
constexpr int NAID = 2 * NROWS;
constexpr int MAXSLOT = 43008;
constexpr float LN_EPS = 1e-6f;
constexpr float ALPHA = 1.4142135623730951f;
constexpr float F2SCALE = 16.f, F2SCALE_INV = 1.f / 16.f;
constexpr float WSCALE = 32.f, WSCALE_INV = 1.f / 32.f;

constexpr size_t MiB = 1u << 20;
constexpr size_t WS_CTL = 0, CTL_BYTES = 2 * MiB;
constexpr int CW_BAR = 0;
constexpr int CW_CNT = 4096;
constexpr int CW_SS = 8192;
constexpr int CW_CONV = 4608;
constexpr int CW_MOD = 65536;
static_assert((size_t)(CW_MOD + 2 * 5 * 12288) * 4 <= CTL_BYTES, "ctl region");
constexpr size_t WS_T32 = 2 * MiB;
constexpr size_t WS_T16 = WS_T32 + (size_t)4352 * 32 * 8;
constexpr size_t WS_SSP = 3 * MiB + 256 * 1024;
constexpr size_t WS_WR = 4 * MiB;
constexpr size_t WS_WUKV = 5 * MiB;
constexpr size_t WS_WOUT = 6 * MiB;
constexpr size_t WS_WIN = WS_WOUT + 16 * MiB;
constexpr size_t WS_WGU = WS_WIN + 44 * MiB;
constexpr size_t WS_WDN = WS_WGU + 256 * MiB;
constexpr size_t WS_H8 = WS_WDN + 128 * MiB;
constexpr size_t WS_X = WS_H8 + 34 * MiB;
constexpr size_t WS_H = WS_X + 136 * MiB;
constexpr size_t R768 = (size_t)NROWS * 768 * 2, R256 = (size_t)NROWS * 256 * 2, R384 = (size_t)NROWS * 384 * 2, R512 = (size_t)NROWS * 512 * 2, R2048 = (size_t)NROWS * 2048 * 2;
constexpr size_t WS_SQ = WS_H + 68 * MiB;
constexpr size_t WS_SK = WS_SQ + R768, WS_SV = WS_SK + R256, WS_RQ = WS_SV + R256, WS_RK = WS_RQ + R384, WS_RV = WS_RK + R384;
constexpr size_t WS_RGF = WS_RV + R768, WS_RGB = WS_RGF + R768, WS_MQ = WS_RGB + R768, WS_CKV = WS_MQ + R768, WS_KF = WS_CKV + R256, WS_MV = WS_KF + R768;
constexpr size_t WS_MIX = WS_MV + R512, WS_Y = WS_MIX + R2048;
constexpr size_t KVI_BYTES = (size_t)2 * 4 * 6 * 34 * 8192 * 4;
constexpr size_t WS_KVI = WS_Y + R2048, WS_SPREV = WS_KVI + KVI_BYTES;
constexpr size_t WS_MIX8 = WS_KVI + 8 * MiB;
constexpr size_t WS_LISTE = WS_SPREV + KVI_BYTES / 2;
constexpr size_t WS_AW = WS_LISTE + (size_t)NEXP * NAID * 4;
constexpr size_t WS_ACT = WS_AW + (size_t)NAID * 4;
constexpr size_t WS_F2 = WS_ACT + (size_t)MAXSLOT * EH;
constexpr size_t WS_END = WS_F2 + (size_t)NAID * 2048;

constexpr int RING_BYTES = 131072;
constexpr int MISC_OFF = RING_BYTES;
constexpr int EPI_OFF = RING_BYTES + 4096, EPI_SLAB = 16 * 144;
constexpr int LDS_BYTES = EPI_OFF + 8 * EPI_SLAB;
constexpr int NWAVES = 8, NTHREADS = 512;

__device__ __forceinline__ unsigned cvtpk(float lo, float hi) { unsigned r; asm volatile("v_cvt_pk_bf16_f32 %0, %1, %2" : "=v"(r) : "v"(lo), "v"(hi)); return r; }
__device__ __forceinline__ unsigned pk_fp8x4(float a, float b, float c, float d) { int r = 0; r = __builtin_amdgcn_cvt_pk_fp8_f32(a, b, r, false); r = __builtin_amdgcn_cvt_pk_fp8_f32(c, d, r, true); return (unsigned)r; }
__device__ __forceinline__ float bflo(unsigned w) { return __uint_as_float(w << 16); }
__device__ __forceinline__ float bfhi(unsigned w) { return __uint_as_float(w & 0xffff0000u); }
__device__ __forceinline__ int lane_id_fresh() { unsigned m = ~0u; asm volatile("" : "+s"(m)); return (int)__builtin_amdgcn_mbcnt_hi(m, __builtin_amdgcn_mbcnt_lo(m, 0u)); }
template <int CTRL> __device__ __forceinline__ float dpp_f(float v) { return __int_as_float(__builtin_amdgcn_update_dpp(0, __float_as_int(v), CTRL, 0xf, 0xf, true)); }
__device__ __forceinline__ float xor16_f(float v) { return __int_as_float(__builtin_amdgcn_ds_swizzle(__float_as_int(v), 0x401f)); }
__device__ __forceinline__ float sum_xor32(float v) { auto sw = __builtin_amdgcn_permlane32_swap(__float_as_uint(v), __float_as_uint(v), false, false); return __uint_as_float(sw[0]) + __uint_as_float(sw[1]); }
__device__ __forceinline__ float row16_sum(float v) {
    v += dpp_f<0xB1>(v); v += dpp_f<0x4E>(v); v += dpp_f<0x124>(v); v += dpp_f<0x128>(v); return v; }
__device__ __forceinline__ float wave_sum(float v) { v = row16_sum(v); v += xor16_f(v); return sum_xor32(v); }
__device__ __forceinline__ float siluf(float x) { return x * __builtin_amdgcn_rcpf(1.f + __expf(-x)); }
__device__ __forceinline__ void st8(bf16_t* p, const f32x4 v) { u32x2 w; w.x = cvtpk(v.x, v.y); w.y = cvtpk(v.z, v.w); *(u32x2*)p = w; }
#define LDS_WAIT() asm volatile("s_waitcnt lgkmcnt(0)" ::: "memory")
#define VM_WAIT() asm volatile("s_waitcnt vmcnt(0)" ::: "memory")

__device__ const float INVF32[32] = {
    1.000000000e+00f, 7.498942093e-01f, 5.623413252e-01f, 4.216965034e-01f, 3.162277660e-01f, 2.371373706e-01f, 1.778279410e-01f, 1.333521432e-01f,
    1.000000000e-01f, 7.498942093e-02f, 5.623413252e-02f, 4.216965034e-02f, 3.162277660e-02f, 2.371373706e-02f, 1.778279410e-02f, 1.333521432e-02f,
    1.000000000e-02f, 7.498942093e-03f, 5.623413252e-03f, 4.216965034e-03f, 3.162277660e-03f, 2.371373706e-03f, 1.778279410e-03f, 1.333521432e-03f,
    1.000000000e-03f, 7.498942093e-04f, 5.623413252e-04f, 4.216965034e-04f, 3.162277660e-04f, 2.371373706e-04f, 1.778279410e-04f, 1.333521432e-04f};

#define XB_TMO      128
#define XB_XCNT(j)  (256  + 64 * (j))
#define XB_XSUB(j)  (1280 + 64 * (j))
#define XB_XGEN(j)  (2304 + 64 * (j))
#define XB_TOP      3328
#define XB_TOPGEN   3392
#define XCD_BAR_WORDS 3456
#define XB_SPIN_CAP (1u << 18)
__device__ __forceinline__ unsigned xb_ld(unsigned* p)              { return __hip_atomic_load(p, __ATOMIC_RELAXED, __HIP_MEMORY_SCOPE_AGENT); }
__device__ __forceinline__ unsigned xb_add(unsigned* p, unsigned v) { return __hip_atomic_fetch_add(p, v, __ATOMIC_RELAXED, __HIP_MEMORY_SCOPE_AGENT); }
__device__ __forceinline__ unsigned xb_xcc_id() { return (unsigned)__builtin_amdgcn_s_getreg((3 << 11) | 20) & 0xFu; }
#define XB_SPIN(cond, bar) do { unsigned _sp = 0; while (cond) { __builtin_amdgcn_s_sleep(1); \
    if ((++_sp & 255u) == 0u) { if (xb_ld(&(bar)[XB_TMO])) break; if (_sp > XB_SPIN_CAP) { atomicAdd(&(bar)[XB_TMO], 1u); break; } } } } while (0)
struct XcdBarrier { unsigned* bar; unsigned x; volatile LAS unsigned* st; };
__device__ __forceinline__ XcdBarrier xcd_barrier_post(unsigned* bar, volatile LAS unsigned* st) {
    XcdBarrier b; b.bar = bar; b.x = xb_xcc_id(); b.st = st;
    if (threadIdx.x == 0) (void)xb_add(&bar[XB_XCNT(b.x)], 1u);
    return b;
}
__device__ __forceinline__ void xcd_barrier_complete(unsigned* bar, unsigned x, unsigned& nloc, unsigned& nx) {
    const unsigned G = gridDim.x * gridDim.y * gridDim.z;
    unsigned sum, cnt, mine, sp = 0u;
    for (;;) {
        sum = 0u; cnt = 0u; mine = 0u;
#pragma unroll
        for (unsigned j = 0; j < 16; ++j) { const unsigned c = xb_ld(&bar[XB_XCNT(j)]); sum += c; cnt += (c > 0u) ? 1u : 0u; mine = (j == x) ? c : mine; }
        if (sum == G) break;
        __builtin_amdgcn_s_sleep(1);
        if ((++sp & 255u) == 0u) { if (xb_ld(&bar[XB_TMO])) break; if (sp > XB_SPIN_CAP) { atomicAdd(&bar[XB_TMO], 1u); break; } }
    }
    nloc = mine > 0u ? mine : 1u; nx = cnt > 0u ? cnt : 1u;
}
__device__ __forceinline__ void xcd_barrier(const XcdBarrier& b0, int wave_) {
    XcdBarrier b; b.bar = b0.bar; b.st = b0.st; b.x = xb_xcc_id();
    asm volatile("s_waitcnt vmcnt(0)" ::: "memory");
    __syncthreads();
    const int t0_ = wave_ * 64 + lane_id_fresh();
    if (t0_ == 0) {
        unsigned* bar = b.bar;
        __builtin_amdgcn_s_waitcnt(0);
        unsigned nloc = b.st[0], nx = b.st[1];
        if (nloc == 0u) { xcd_barrier_complete(bar, b.x, nloc, nx); b.st[0] = nloc; b.st[1] = nx; }
        const unsigned old = xb_add(&bar[XB_XSUB(b.x)], 1u);
        const unsigned gen = old / nloc;
        if (old + 1u == (gen + 1u) * nloc) {
            __builtin_amdgcn_fence(__ATOMIC_RELEASE, "agent");
            asm volatile("s_waitcnt vmcnt(0)" ::: "memory");
            const unsigned og = xb_add(&bar[XB_TOP], 1u);
            const unsigned tg = og / nx;
            if (og + 1u == (tg + 1u) * nx) xb_add(&bar[XB_TOPGEN], 1u);
            else XB_SPIN(xb_ld(&bar[XB_TOPGEN]) == tg, bar);
            __builtin_amdgcn_fence(__ATOMIC_ACQUIRE, "agent");
            xb_add(&bar[XB_XGEN(b.x)], 1u);
            asm volatile("s_waitcnt vmcnt(0)" ::: "memory");
        } else {
            XB_SPIN(xb_ld(&bar[XB_XGEN(b.x)]) == gen, bar);
            __builtin_amdgcn_fence(__ATOMIC_ACQUIRE, "agent");
            asm volatile("s_waitcnt vmcnt(0)" ::: "memory");
        }
    }
    __syncthreads();
}

struct Params {
    const float* in[24];
    float* out;
    unsigned char* ws;
    int ph_lo, ph_hi;
};
enum { I_X = 0, I_C, I_CTX, I_CCTX, I_WADA, I_BADA, I_WIN, I_SINK, I_RDEC, I_KVN, I_WUK, I_WUV, I_WOUT, I_LN1G, I_LN1B, I_LN2G, I_LN2B,
       I_WGRP, I_BGRP, I_WEXP, I_BEXP, I_WGATE, I_WUP, I_WDOWN };

struct Frame {
    LAS unsigned char* lds;
    unsigned char* ws;
    unsigned* ctl;
    int tid, lane, wave, G, bx;
};
__device__ __forceinline__ Frame fresh_frame(const Frame& F0) {
    Frame F = F0; int w = F0.wave; asm volatile("" : "+s"(w)); F.wave = w; F.lane = lane_id_fresh(); F.tid = w * 64 + F.lane;
    size_t z = 0; asm volatile("" : "+s"(z)); F.ws = F0.ws + z; F.ctl = (unsigned*)(F.ws + WS_CTL);
    return F;
}

__device__ __forceinline__ void tr_item(const float* W, int N, int K, int k0, int n0, bf16_t* WT, int rb0, int rb1, const float* kscale, int lane) {
    const int kg = lane >> 3, n4 = lane & 7;
    const float* src = W + (size_t)(k0 + 8 * kg) * N + n0 + 4 * n4;
    f32x4 v[8];
#pragma unroll
    for (int j = 0; j < 8; ++j) v[j] = __builtin_nontemporal_load((const f32x4*)(src + (size_t)j * N));
    if (kscale) {
#pragma unroll
        for (int j = 0; j < 8; ++j) v[j] *= kscale[k0 + 8 * kg + j];
    }
#pragma unroll
    for (int i = 0; i < 4; ++i) { const int n = 4 * n4 + i; const int row = (n < 16) ? rb0 + n : rb1 + n - 16;
        u32x4 o; o.x = cvtpk(v[0][i], v[1][i]); o.y = cvtpk(v[2][i], v[3][i]); o.z = cvtpk(v[4][i], v[5][i]); o.w = cvtpk(v[6][i], v[7][i]);
        *(u32x4*)(WT + (size_t)row * K + k0 + 8 * kg) = o; }
}
template <bool TILED = false>
__device__ __forceinline__ void tr_item8(const float* W, int N, int K, int k0, int n0, unsigned char* WT, int rb0, int rb1, int lane) {
    const int kg = lane >> 3, n4 = lane & 7;
    const float* src = W + (size_t)(k0 + 16 * kg) * N + n0 + 4 * n4;
    f32x4 v[16];
#pragma unroll
    for (int j = 0; j < 16; ++j) v[j] = __builtin_nontemporal_load((const f32x4*)(src + (size_t)j * N)) * WSCALE;
#pragma unroll
    for (int i = 0; i < 4; ++i) { const int n = 4 * n4 + i; const int row = (n < 16) ? rb0 + n : rb1 + n - 16;
        u32x4 o; o.x = pk_fp8x4(v[0][i], v[1][i], v[2][i], v[3][i]); o.y = pk_fp8x4(v[4][i], v[5][i], v[6][i], v[7][i]);
        o.z = pk_fp8x4(v[8][i], v[9][i], v[10][i], v[11][i]); o.w = pk_fp8x4(v[12][i], v[13][i], v[14][i], v[15][i]);
        if (TILED) *(u32x4*)(WT + (size_t)(row >> 8) * 256 * K + (size_t)k0 * 256 + (row & 255) * 128 + 16 * kg) = o;
        else *(u32x4*)(WT + (size_t)row * K + k0 + 16 * kg) = o; }
}
struct Tr8Src { const float* src; int N; unsigned char* dst; int K, k0, rb0, rb1; };
__device__ __forceinline__ void tr8_load(const Tr8Src& t, int lane, f32x4 (&v)[16]) {
    const int kg = lane >> 3, n4 = lane & 7; const float* p = t.src + (size_t)(t.k0 + 16 * kg) * t.N + 4 * n4;
#pragma unroll
    for (int j = 0; j < 16; ++j) v[j] = __builtin_nontemporal_load((const f32x4*)(p + (size_t)j * t.N));
}
__device__ __forceinline__ void tr8_store(const Tr8Src& t, int lane, const f32x4 (&v)[16]) {
    const int kg = lane >> 3, n4 = lane & 7;
#pragma unroll
    for (int i = 0; i < 4; ++i) { const int n = 4 * n4 + i; const int row = (n < 16) ? t.rb0 + n : t.rb1 + n - 16;
        u32x4 o; o.x = pk_fp8x4(v[0][i] * WSCALE, v[1][i] * WSCALE, v[2][i] * WSCALE, v[3][i] * WSCALE); o.y = pk_fp8x4(v[4][i] * WSCALE, v[5][i] * WSCALE, v[6][i] * WSCALE, v[7][i] * WSCALE);
        o.z = pk_fp8x4(v[8][i] * WSCALE, v[9][i] * WSCALE, v[10][i] * WSCALE, v[11][i] * WSCALE); o.w = pk_fp8x4(v[12][i] * WSCALE, v[13][i] * WSCALE, v[14][i] * WSCALE, v[15][i] * WSCALE);
        __builtin_nontemporal_store(o, (u32x4*)(t.dst + (size_t)(row >> 8) * 256 * t.K + (size_t)t.k0 * 256 + (row & 255) * 128 + 16 * kg)); }
}
__device__ __forceinline__ int map16w(int n16) { const int tile = n16 >> 4, s16 = n16 & 15; return tile * 256 + (8 * ((s16 >> 1) & 1) + 2 * (s16 >> 2) + (s16 & 1)) * 16; }
#ifndef MK_F8MASK
#define MK_F8MASK 0x1F800u
#endif
constexpr unsigned F8MASK = MK_F8SEL ? MK_F8MASK : 0u, BFMASK = 0x3FFFFFu & ~F8MASK;
constexpr int F8N1 = __builtin_popcount(F8MASK);
__device__ __forceinline__ int nth_bit(unsigned m, int i) { for (int k = 0; k < i; ++k) m &= m - 1u; return __builtin_ctz(m); }
constexpr int NB16 = 170 - 8 * F8N1, S_IN0 = 32 * NB16, S_IN1 = 16 * 170, S_IN8 = 16 * 8 * F8N1;
constexpr int S_IN = S_IN0 + S_IN1 + S_IN8, S_OUT = MK_OUT8 ? 2 * 16 * 64 : 2 * 32 * 64, S_UKV = 256, S_GU = 2 * 32 * 2 * 512, S_DN = 2 * 32 * 512;
constexpr int S_ALL = S_IN + S_OUT + S_UKV + S_GU + S_DN;

constexpr int MOE_ITEMS_L = 32768 + 16384, MOE_ITEMS = 2 * MOE_ITEMS_L;
__device__ __forceinline__ void moe_conv_item(const Params& P, unsigned char* ws, int idx, int lane) {
    const int l = (idx >= MOE_ITEMS_L) ? 1 : 0; int r = idx - l * MOE_ITEMS_L;
    if (r < 32768) { const int le = l * 32 + (r >> 10); r &= 1023; const int which = r >> 9; r &= 511; const int kb = r >> 5, nb = r & 31;
        if (which) tr_item8<true>(P.in[I_WUP] + (size_t)le * D * EH, EH, D, 128 * kb, 32 * nb, ws + WS_WGU + (size_t)le * 2048 * D, 64 * nb + 16, 64 * nb + 48, lane);
        else tr_item8<true>(P.in[I_WGATE] + (size_t)le * D * EH, EH, D, 128 * kb, 32 * nb, ws + WS_WGU + (size_t)le * 2048 * D, 64 * nb, 64 * nb + 32, lane); }
    else { r -= 32768; const int le = l * 32 + (r >> 9); r &= 511; const int kb = r >> 6, nb = r & 63;
        tr_item8<true>(P.in[I_WDOWN] + (size_t)le * EH * D, D, EH, 128 * kb, 32 * nb, ws + WS_WDN + (size_t)le * D * EH, 32 * nb, 32 * nb + 16, lane); }
}
__device__ __forceinline__ Tr8Src moe_item_desc(const Params& P, unsigned char* ws, int idx) {
    Tr8Src t; const int l = (idx >= MOE_ITEMS_L) ? 1 : 0; int r = idx - l * MOE_ITEMS_L;
    if (r < 32768) { const int le = l * 32 + (r >> 10); r &= 1023; const int which = r >> 9; r &= 511; const int kb = r >> 5, nb = r & 31;
        t.src = (which ? P.in[I_WUP] : P.in[I_WGATE]) + (size_t)le * D * EH + 32 * nb; t.N = EH; t.dst = ws + WS_WGU + (size_t)le * 2048 * D; t.K = D; t.k0 = 128 * kb; t.rb0 = 64 * nb + 16 * which; t.rb1 = t.rb0 + 32; }
    else { r -= 32768; const int le = l * 32 + (r >> 9); r &= 511; const int kb = r >> 6, nb = r & 63;
        t.src = P.in[I_WDOWN] + (size_t)le * EH * D + 32 * nb; t.N = D; t.dst = ws + WS_WDN + (size_t)le * D * EH; t.K = EH; t.k0 = 128 * kb; t.rb0 = 32 * nb; t.rb1 = t.rb0 + 16; }
    return t;
}
__device__ __forceinline__ int conv_claim16(const Frame& F) {
    int b = 0; if (F.lane == 0) b = (int)__hip_atomic_fetch_add(F.ctl + CW_CONV, 16u, __ATOMIC_RELAXED, __HIP_MEMORY_SCOPE_AGENT);
    return __builtin_amdgcn_readfirstlane(b);
}
__device__ __forceinline__ unsigned sload_fresh(const unsigned* p) { unsigned v; asm volatile("s_load_dword %0, %1, 0x0 glc\n\ts_waitcnt lgkmcnt(0)" : "=s"(v) : "s"(p) : "memory"); return v; }
__device__ __forceinline__ void converter_slot(const Frame& F, const Params& P, int slot, int must_end, int ncomp, bool join = false) {
    if (MK_CONVPROBE == 1) return;
    if (MK_CONVPROBE == 2) must_end = 0;
    const unsigned* done = F.ctl + CW_CONV + 64 * (1 + slot);
    volatile LAS int* cb = (volatile LAS int*)(F.lds + MISC_OFF + 32);
    f32x4 va[16], vb[16];
    if (F.wave == 0) { int b = MOE_ITEMS;
        const bool skip = join && (sload_fresh(done) >= (unsigned)ncomp) && ((int)sload_fresh(F.ctl + CW_CONV) >= must_end);
        if (!skip) b = conv_claim16(F); if (F.lane == 0) cb[0] = b; }
    asm volatile("s_waitcnt lgkmcnt(0)" ::: "memory"); __builtin_amdgcn_s_barrier();
    int base = __builtin_amdgcn_readfirstlane(cb[0]), par = 1;
    while (base < MOE_ITEMS) {
        const Tr8Src t0 = moe_item_desc(P, F.ws, base + 2 * F.wave), t1 = moe_item_desc(P, F.ws, base + 2 * F.wave + 1);
        tr8_load(t0, F.lane, va); tr8_load(t1, F.lane, vb);
        if (F.wave == 0) {
            const bool stop = (base + 16 >= must_end) && (sload_fresh(done) >= (unsigned)ncomp);
            int nb = MOE_ITEMS; if (!stop) nb = conv_claim16(F);
            if (F.lane == 0) cb[par] = nb;
        }
        tr8_store(t0, F.lane, va); tr8_store(t1, F.lane, vb);
        asm volatile("s_waitcnt lgkmcnt(0)" ::: "memory"); __builtin_amdgcn_s_barrier();
        base = __builtin_amdgcn_readfirstlane(cb[par]); par ^= 1;
    }
}
__device__ __forceinline__ void conv_snapshot(const Frame& F) { if (F.bx == 0 && F.wave == 0 && lane_id_fresh() == 0) { const unsigned c = __hip_atomic_load(F.ctl + CW_CONV, __ATOMIC_RELAXED, __HIP_MEMORY_SCOPE_AGENT); __hip_atomic_store(F.ctl + CW_CONV + 32, c, __ATOMIC_RELAXED, __HIP_MEMORY_SCOPE_AGENT); } }
__device__ __forceinline__ int conv_remaining(const Frame& F) { const int c = __builtin_amdgcn_readfirstlane((int)__hip_atomic_load(F.ctl + CW_CONV + 32, __ATOMIC_RELAXED, __HIP_MEMORY_SCOPE_AGENT)); return c >= MOE_ITEMS ? 0 : MOE_ITEMS - c; }
__device__ __forceinline__ void conv_signal(const Frame& F, int slot) { if (F.tid == 0) __hip_atomic_fetch_add(F.ctl + CW_CONV + 64 * (1 + slot), 1u, __ATOMIC_RELAXED, __HIP_MEMORY_SCOPE_AGENT); }
constexpr int NCONV = 42, NCONV_OUT = 74;

__device__ __forceinline__ void p0_prologue(const Frame& F, const Params& P) {
    unsigned char* ws = F.ws;
    {
        LAS float* sc = (LAS float*)F.lds;
        LAS float* red = sc + 5 * D;
        float* MOD = (float*)(F.ctl + CW_MOD);
        if (F.bx < 192) {
            for (int idx = F.tid; idx < 5 * D; idx += NTHREADS) { const int r = idx >> 11, k = idx & 2047; const float c = (r < 4) ? P.in[I_C][r * D + k] : P.in[I_CCTX][k]; sc[idx] = siluf(c); }
            __syncthreads();
        }
        for (int u = F.bx; u < 192; u += F.G) {
            const int l = u / 96, nblk = u % 96;
            const float* W = P.in[I_WADA] + ((size_t)l * D + 256 * F.wave) * 12288 + 128 * nblk + 2 * F.lane;
            f32x2 a0 = {0.f, 0.f}, a1 = a0, a2 = a0, a3 = a0, a4 = a0;
#pragma unroll 8
            for (int kk = 0; kk < 256; ++kk) { const f32x2 w = __builtin_nontemporal_load((const f32x2*)(W + (size_t)kk * 12288)); const int k = 256 * F.wave + kk;
                const float s0 = sc[k], s1 = sc[D + k], s2 = sc[2 * D + k], s3 = sc[3 * D + k], s4 = sc[4 * D + k];
                a0.x += s0 * w.x; a0.y += s0 * w.y; a1.x += s1 * w.x; a1.y += s1 * w.y; a2.x += s2 * w.x; a2.y += s2 * w.y; a3.x += s3 * w.x; a3.y += s3 * w.y; a4.x += s4 * w.x; a4.y += s4 * w.y; }
            LAS float* rw = red + F.wave * 640 + 2 * F.lane;
            *(LAS f32x2*)(rw) = a0; *(LAS f32x2*)(rw + 128) = a1; *(LAS f32x2*)(rw + 256) = a2; *(LAS f32x2*)(rw + 384) = a3; *(LAS f32x2*)(rw + 512) = a4;
            __syncthreads();
            for (int idx = F.tid; idx < 640; idx += NTHREADS) { const int r = idx >> 7, col = idx & 127; float s = 0.f;
#pragma unroll
                for (int w = 0; w < 8; ++w) s += red[w * 640 + idx];
                MOD[((size_t)l * 5 + r) * 12288 + 128 * nblk + col] = s + P.in[I_BADA][l * 12288 + 128 * nblk + col]; }
            __syncthreads();
        }
        __syncthreads();
    }
    {
        const int gt = F.bx * NTHREADS + F.tid, GT = F.G * NTHREADS;
        float2* T32 = (float2*)(ws + WS_T32); float2* T16 = (float2*)(ws + WS_T16);
        for (int idx = gt; idx < 4352 * 32 + 64 * 16; idx += GT) {
            int pos, f; float inv; float2* dst;
            if (idx < 4352 * 32) { pos = idx >> 5; f = idx & 31; inv = INVF32[f]; dst = T32 + idx; }
            else { const int j = idx - 4352 * 32; pos = j >> 4; f = j & 15; inv = INVF32[2 * f]; dst = T16 + j; }
            double rev = (double)pos * (double)inv * 0.15915494309189535; rev -= __builtin_rint(rev);
            const float fr = (float)rev; float2 cs; cs.x = __builtin_amdgcn_cosf(fr); cs.y = __builtin_amdgcn_sinf(fr); *dst = cs;
        }
        bf16_t* WR = (bf16_t*)(ws + WS_WR);
        for (int idx = gt; idx < 2 * 48 * 2048; idx += GT) { const int l = idx / (48 * 2048), r = idx % (48 * 2048), n = r >> 11, k = r & 2047; float v = 0.f;
            if (n < 4) v = P.in[I_WGRP][((size_t)l * D + k) * 4 + n]; else if (n < 36) v = P.in[I_WEXP][((size_t)l * D + k) * 32 + (n - 4)];
            WR[idx] = (bf16_t)(cvtpk(v, 0.f) & 0xffffu); }
        u32x4* WIN4 = (u32x4*)(ws + WS_WIN);
        for (int idx = gt; idx < 192 * 256 + 192 * 128; idx += GT) {
            if (idx < 192 * 256) { const int p = idx >> 8, row = 21 * 256 + (p < 96 ? 32 + p : 64 + p); WIN4[(size_t)row * 256 + (idx & 255)] = (u32x4){0u, 0u, 0u, 0u}; }
            else { const int i2 = idx - 192 * 256, p = i2 >> 7, row = 21 * 256 + (p < 96 ? 32 + p : 64 + p); WIN4[(size_t)INWP * 256 + (size_t)row * 128 + (i2 & 127)] = (u32x4){0u, 0u, 0u, 0u}; } }
    }
    {
        const int gw = F.bx * NWAVES + F.wave, NGW = F.G * NWAVES;
        const int nitems = S_IN + S_OUT + S_UKV + ((F.G == 256 && MK_CONVPROBE == 0) ? 0 : MOE_ITEMS);
        for (int it = gw; it < nitems; it += NGW) {
            int r = it; int kb, nb;
            if (r < S_IN) {
                if (r < S_IN0) { kb = r / NB16; nb = r % NB16; nb = 8 * nth_bit(BFMASK, nb >> 3) + (nb & 7);
                    tr_item(P.in[I_WIN], INW, D, 64 * kb, 32 * nb, (bf16_t*)(ws + WS_WIN), map16w(2 * nb), map16w(2 * nb + 1), nullptr, F.lane); }
                else if (r < S_IN0 + S_IN1) { r -= S_IN0; kb = r / 170; nb = r % 170;
                    tr_item8(P.in[I_WIN] + (size_t)D * INW, INW, D, 128 * kb, 32 * nb, ws + WS_WIN + (size_t)INWP * D * 2, map16w(2 * nb), map16w(2 * nb + 1), F.lane); }
                else { r -= S_IN0 + S_IN1; kb = r / (8 * F8N1 + (F8N1 == 0)); nb = r % (8 * F8N1 + (F8N1 == 0)); nb = 8 * nth_bit(F8MASK | (F8N1 == 0), nb >> 3) + (nb & 7);
                    tr_item8(P.in[I_WIN], INW, D, 128 * kb, 32 * nb, ws + WS_WIN + (size_t)INWP * D * 3, map16w(2 * nb), map16w(2 * nb + 1), F.lane); }
                continue; }
            else if (MK_OUT8 && (r - S_IN) < S_OUT) { r -= S_IN; const int l = r / 1024; r %= 1024; kb = r >> 6; nb = r & 63;
                tr_item8(P.in[I_WOUT] + (size_t)l * D * D, D, D, 128 * kb, 32 * nb, ws + WS_WOUT + (size_t)l * D * D, map16w(2 * nb), map16w(2 * nb + 1), F.lane); continue; }
            else if ((r -= S_IN) < S_OUT) { const int l = r / 2048; r %= 2048; kb = r >> 6; nb = r & 63;
                tr_item(P.in[I_WOUT] + (size_t)l * D * D, D, D, 64 * kb, 32 * nb, (bf16_t*)(ws + WS_WOUT) + (size_t)l * D * D, map16w(2 * nb), map16w(2 * nb + 1), nullptr, F.lane); continue; }
            else if ((r -= S_OUT) < S_UKV) { const int l = r >> 7; r &= 127; const int which = r >> 6; r &= 63; kb = r >> 4; nb = r & 15;
                bf16_t* dst = (bf16_t*)(ws + WS_WUKV) + (size_t)l * 1024 * 256; const float* ksc = P.in[I_KVN] + l * 256;
                if (which) tr_item(P.in[I_WUV] + (size_t)l * 256 * 512, 512, 256, 64 * kb, 32 * nb, dst, 512 + map16w(2 * nb), 512 + map16w(2 * nb + 1), ksc, F.lane);
                else tr_item(P.in[I_WUK] + (size_t)l * 256 * 512, 512, 256, 64 * kb, 32 * nb, dst, map16w(2 * nb), map16w(2 * nb + 1), ksc, F.lane);
                continue; }
            else { r -= S_UKV; moe_conv_item(P, ws, r, F.lane); continue; }
        }
    }
}

__device__ __forceinline__ void ln_stats(const f32x4 (&v)[8], float& mean, float& rstd) {
    float s = 0.f;
#pragma unroll
    for (int j = 0; j < 8; ++j) s += (v[j].x + v[j].y) + (v[j].z + v[j].w);
    mean = wave_sum(s) * (1.f / D);
    float s2 = 0.f;
#pragma unroll
    for (int j = 0; j < 8; ++j) { const f32x4 d = v[j] - mean; s2 += (d.x * d.x + d.y * d.y) + (d.z * d.z + d.w * d.w); }
    rstd = __builtin_amdgcn_rsqf(wave_sum(s2) * (1.f / D) + LN_EPS);
}
template <bool WITH16, bool WITH8>
__device__ __forceinline__ void modulate_store(const f32x4 (&v)[8], const float* shift, const float* scale, bf16_t* hrow, unsigned char* h8row, int lane) {
    float mean, rstd; ln_stats(v, mean, rstd);
#pragma unroll
    for (int j = 0; j < 8; ++j) { const f32x4 sh = ((const f32x4*)shift)[lane + 64 * j], sc = ((const f32x4*)scale)[lane + 64 * j];
        const f32x4 o = (v[j] - mean) * rstd * (sc + 1.f) + sh;
        if (WITH16) { u32x2 w; w.x = cvtpk(o.x, o.y); w.y = cvtpk(o.z, o.w); ((u32x2*)hrow)[lane + 64 * j] = w; }
        if (WITH8) ((unsigned*)h8row)[lane + 64 * j] = pk_fp8x4(o.x, o.y, o.z, o.w); }
}
__device__ __forceinline__ void affine_ln(f32x4 (&v)[8], const float* g, const float* b, int lane) {
    float mean, rstd; ln_stats(v, mean, rstd);
#pragma unroll
    for (int j = 0; j < 8; ++j) { const f32x4 gg = ((const f32x4*)g)[lane + 64 * j], bb = ((const f32x4*)b)[lane + 64 * j]; v[j] = (v[j] - mean) * rstd * gg + bb; }
}
__device__ __forceinline__ const float* src_row0(const Params& P, int r) {
    const int b = r / TPB, j = r - b * TPB;
    return j < NCTX ? P.in[I_CTX] + ((size_t)b * NCTX + j) * D : P.in[I_X] + ((size_t)b * SEQ + (j - NCTX)) * D;
}
__device__ __forceinline__ int mod_row(int r) { const int b = r / TPB, j = r - b * TPB; return j < NCTX ? 4 : b; }
__device__ __forceinline__ int latent_row(int q) { return (q >> 12) * TPB + NCTX + (q & 4095); }

__device__ __forceinline__ void row_load_bf16(const bf16_t* p, int lane, f32x4 (&v)[8]) {
#pragma unroll
    for (int j = 0; j < 8; ++j) { const u32x2 a = ((const u32x2*)p)[lane + 64 * j]; v[j] = (f32x4){bflo(a.x), bfhi(a.x), bflo(a.y), bfhi(a.y)}; }
}
__device__ __forceinline__ void row_store_bf16(bf16_t* p, int lane, const f32x4 (&v)[8]) {
#pragma unroll
    for (int j = 0; j < 8; ++j) { u32x2 w; w.x = cvtpk(v[j].x, v[j].y); w.y = cvtpk(v[j].z, v[j].w); ((u32x2*)p)[lane + 64 * j] = w; }
}
__device__ __forceinline__ void phase_r1(const Frame& F, const Params& P) {
    const float* MOD = (const float*)(F.ctl + CW_MOD); bf16_t* H = (bf16_t*)(F.ws + WS_H);
    const int gw = F.bx * NWAVES + F.wave, NGW = F.G * NWAVES;
    for (int r = gw; r < NROWS; r += NGW) {
        const float* xr = src_row0(P, r); f32x4 v[8];
#pragma unroll
        for (int j = 0; j < 8; ++j) v[j] = ((const f32x4*)xr)[F.lane + 64 * j];
        const float* m = MOD + (size_t)mod_row(r) * 12288;
        modulate_store<true, (MK_F8SEL != 0)>(v, m, m + D, H + (size_t)r * D, (unsigned char*)(F.ws + WS_H8) + (size_t)r * D, F.lane);
    }
}
__device__ __forceinline__ void phase_r7(const Frame& F, const Params& P, int l) {
    const float* MOD = (const float*)(F.ctl + CW_MOD); bf16_t* H = (bf16_t*)(F.ws + WS_H); bf16_t* X = (bf16_t*)(F.ws + WS_X); const unsigned char* F2 = (const unsigned char*)(F.ws + WS_F2);
    const bool last = (l == DEPTH - 1); const int NR = last ? NBATCH * SEQ : NROWS;
    const int gw = F.bx * NWAVES + F.wave, NGW = F.G * NWAVES;
    for (int q = gw; q < NR; q += NGW) {
        const int r = last ? latent_row(q) : q; const int mr = mod_row(r);
        bf16_t* xr = X + (size_t)r * D; f32x4 v[8], xv[8]; row_load_bf16(xr, F.lane, xv);
        const float* gate = MOD + ((size_t)l * 5 + mr) * 12288 + 5 * D;
        const unsigned* f0 = (const unsigned*)(F2 + (size_t)(2 * r) * D); const unsigned* f1 = (const unsigned*)(F2 + (size_t)(2 * r + 1) * D);
#pragma unroll
        for (int j = 0; j < 8; ++j) { const f32x4 x = xv[j], g = ((const f32x4*)gate)[F.lane + 64 * j]; const unsigned a = f0[F.lane + 64 * j], b = f1[F.lane + 64 * j];
            const auto a0 = __builtin_amdgcn_cvt_pk_f32_fp8((int)a, false), a1 = __builtin_amdgcn_cvt_pk_f32_fp8((int)a, true), b0 = __builtin_amdgcn_cvt_pk_f32_fp8((int)b, false), b1 = __builtin_amdgcn_cvt_pk_f32_fp8((int)b, true);
            f32x4 f; f.x = (a0[0] + b0[0]) * F2SCALE_INV; f.y = (a0[1] + b0[1]) * F2SCALE_INV; f.z = (a1[0] + b1[0]) * F2SCALE_INV; f.w = (a1[1] + b1[1]) * F2SCALE_INV;
            v[j] = x * ALPHA + g * f; }
        affine_ln(v, P.in[I_LN2G] + l * D, P.in[I_LN2B] + l * D, F.lane);
        if (last) { float* o = P.out + (size_t)q * D;
#pragma unroll
            for (int j = 0; j < 8; ++j) ((f32x4*)o)[F.lane + 64 * j] = v[j];
        } else {
            row_store_bf16(xr, F.lane, v);
            const float* m = MOD + ((size_t)(l + 1) * 5 + mr) * 12288;
            modulate_store<false, true>(v, m, m + D, nullptr, (unsigned char*)(F.ws + WS_H8) + (size_t)r * D, F.lane);
        }
    }
}

__device__ __forceinline__ void phase_r4(const Frame& F, const Params& P, int l) {
    const float* MOD = (const float*)(F.ctl + CW_MOD); bf16_t* H = (bf16_t*)(F.ws + WS_H); bf16_t* X = (bf16_t*)(F.ws + WS_X); const bf16_t* Y = (const bf16_t*)(F.ws + WS_Y);
    const bf16_t* WR = (const bf16_t*)(F.ws + WS_WR) + (size_t)l * 48 * D;
    int* LISTE = (int*)(F.ws + WS_LISTE); float* AW = (float*)(F.ws + WS_KVI); unsigned* CNT = F.ctl + CW_CNT + 64 * l;
    const bool last = (l == DEPTH - 1); const int NR = last ? NBATCH * SEQ : NROWS;
    int g_ = F.G; asm volatile("" : "+s"(g_));
    const int RPB = (NR + g_ - 1) / g_, rbeg = F.bx * RPB, rend = (rbeg + RPB < NR) ? rbeg + RPB : NR;
    LAS float* logits = (LAS float*)F.lds;
    LAS int* cntl = (LAS int*)(F.lds + MISC_OFF + 1024);
    LAS int* basel = cntl + 32;
    const int g16 = F.lane >> 4, l16 = F.lane & 15;
    for (int c0 = rbeg; c0 < rend; c0 += 80) {
        const int nrow = (rend - c0 < 80) ? rend - c0 : 80;
        if (F.tid < 32) cntl[F.tid] = 0;
        for (int i = F.wave; i < nrow; i += NWAVES) {
            const int q = c0 + i, r = last ? latent_row(q) : q, mr = mod_row(r);
            const float* m = MOD + ((size_t)l * 5 + mr) * 12288;
            const u32x2* yr = (const u32x2*)(Y + (size_t)r * D); f32x4 v[8], xv[8];
            if (l == 0) { const float* xr = src_row0(P, r);
#pragma unroll
                for (int j = 0; j < 8; ++j) xv[j] = ((const f32x4*)xr)[F.lane + 64 * j]; }
            else row_load_bf16(X + (size_t)r * D, F.lane, xv);
#pragma unroll
            for (int j = 0; j < 8; ++j) { const f32x4 x = xv[j], g = ((const f32x4*)(m + 2 * D))[F.lane + 64 * j]; const u32x2 a = yr[F.lane + 64 * j];
                f32x4 y; y.x = bflo(a.x); y.y = bfhi(a.x); y.z = bflo(a.y); y.w = bfhi(a.y); v[j] = x * ALPHA + g * y; }
            affine_ln(v, P.in[I_LN1G] + l * D, P.in[I_LN1B] + l * D, F.lane);
            row_store_bf16(X + (size_t)r * D, F.lane, v);
            modulate_store<true, true>(v, m + 3 * D, m + 4 * D, H + (size_t)r * D, (unsigned char*)(F.ws + WS_H8) + (size_t)r * D, F.lane);
        }
        VM_WAIT(); __syncthreads();
        {
            f32x4 acc[5][3];
#pragma unroll
            for (int a = 0; a < 5; ++a)
#pragma unroll
                for (int b = 0; b < 3; ++b) acc[a][b] = (f32x4){0.f, 0.f, 0.f, 0.f};
            const bf16_t* arow[5];
#pragma unroll
            for (int mt = 0; mt < 5; ++mt) { int i = 16 * mt + l16; i = i < nrow ? i : nrow - 1; const int q = c0 + i, r = last ? latent_row(q) : q; arow[mt] = H + (size_t)r * D + 256 * F.wave + 8 * g16; }
            const bf16_t* brow = WR + (size_t)l16 * D + 256 * F.wave + 8 * g16;
#pragma unroll 2
            for (int ks = 0; ks < 8; ++ks) {
                bf16x8 bf[3];
#pragma unroll
                for (int nt = 0; nt < 3; ++nt) bf[nt] = *(const bf16x8*)(brow + (size_t)nt * 16 * D + 32 * ks);
#pragma unroll
                for (int mt = 0; mt < 5; ++mt) { const bf16x8 af = *(const bf16x8*)(arow[mt] + 32 * ks);
#pragma unroll
                    for (int nt = 0; nt < 3; ++nt) acc[mt][nt] = __builtin_amdgcn_mfma_f32_16x16x32_bf16(af, bf[nt], acc[mt][nt], 0, 0, 0); }
            }
#pragma unroll
            for (int mt = 0; mt < 5; ++mt)
#pragma unroll
                for (int nt = 0; nt < 3; ++nt)
#pragma unroll
                    for (int rg = 0; rg < 4; ++rg) logits[F.wave * 3840 + (16 * mt + 4 * g16 + rg) * 48 + 16 * nt + l16] = acc[mt][nt][rg];
        }
        __syncthreads();
        int E1 = 0, E2 = 0, p1 = 0, p2 = 0, r = 0; float w1 = 0.f, w2 = 0.f;
        if (F.tid < nrow) {
            const int q = c0 + F.tid; r = last ? latent_row(q) : q;
            const LAS float* lg = logits + F.tid * 48;
            const float* bg = P.in[I_BGRP] + l * 4; const float* be = P.in[I_BEXP] + l * 32;
            float gl[4];
#pragma unroll
            for (int n = 0; n < 4; ++n) { float a = 0.f;
#pragma unroll
                for (int w = 0; w < 8; ++w) a += lg[w * 3840 + n];
                gl[n] = a + bg[n]; }
            int g = 0; float gm = gl[0];
#pragma unroll
            for (int n = 1; n < 4; ++n) if (gl[n] > gm) { gm = gl[n]; g = n; }
            float gs = 0.f;
#pragma unroll
            for (int n = 0; n < 4; ++n) gs += __expf(gl[n] - gm);
            const float pg = 1.f / gs;
            float e1 = -3.0e38f, e2 = -3.0e38f; int i1 = 0, i2 = 0;
            for (int k = 0; k < 8; ++k) { float e = 0.f;
#pragma unroll
                for (int w = 0; w < 8; ++w) e += lg[w * 3840 + 4 + 8 * g + k];
                e += be[8 * g + k];
                if (e > e1) { e2 = e1; i2 = i1; e1 = e; i1 = k; } else if (e > e2) { e2 = e; i2 = k; } }
            const float s1 = 1.f / (1.f + __expf(e2 - e1));
            w1 = s1 * pg; w2 = (1.f - s1) * pg; E1 = 8 * g + i1; E2 = 8 * g + i2;
            p1 = __hip_atomic_fetch_add(&cntl[E1], 1, __ATOMIC_RELAXED, __HIP_MEMORY_SCOPE_WORKGROUP);
            p2 = __hip_atomic_fetch_add(&cntl[E2], 1, __ATOMIC_RELAXED, __HIP_MEMORY_SCOPE_WORKGROUP);
        }
        __syncthreads();
        if (F.tid < 32) { const int c = cntl[F.tid]; basel[F.tid] = c ? (int)__hip_atomic_fetch_add(&CNT[F.tid], (unsigned)c, __ATOMIC_RELAXED, __HIP_MEMORY_SCOPE_AGENT) : 0; }
        __syncthreads();
        if (F.tid < nrow) {
            LISTE[(size_t)E1 * NAID + basel[E1] + p1] = 2 * r; AW[(size_t)E1 * NAID + basel[E1] + p1] = w1;
            LISTE[(size_t)E2 * NAID + basel[E2] + p2] = 2 * r + 1; AW[(size_t)E2 * NAID + basel[E2] + p2] = w2;
        }
        __syncthreads();
    }
}

namespace pg {
constexpr int BM = 256, BK = 64, HALF = 128, HTB = HALF * BK * 2, NXCD = 8, WGM = 8;
__device__ __forceinline__ int lds_byte(int r, int c) { const int st = (r >> 4) * 2 + (c >> 5), rr = r & 15, cc = c & 31, ob = rr * 64 + cc * 2; return st * 1024 + (ob ^ (((ob >> 9) & 1) << 5)); }
__device__ __forceinline__ void stage_rc(int b, int& R, int& C) { const int st = b / 1024, sb = b % 1024, swz = sb ^ (((sb >> 9) & 1) << 5); R = (st >> 1) * 16 + swz / 64; C = (st & 1) * 32 + (swz % 64) / 2; }
__device__ __forceinline__ bool tile_order(long L, int nM, int nN, int& pm, int& pn) {
    const int nwg = nM * nN; if (L >= nwg) return false;
    int wgid = (int)L; { const int q = nwg / NXCD, r = nwg % NXCD, xcd = wgid % NXCD, off = wgid / NXCD; wgid = (xcd < r ? xcd * (q + 1) : r * (q + 1) + (xcd - r) * q) + off; }
    const int nig = WGM * nN, gid = wgid / nig, fm = gid * WGM, gsz = (nM - fm) < WGM ? (nM - fm) : WGM;
    pm = fm + ((wgid % nig) % gsz); pn = (wgid % nig) / gsz; return true;
}
struct Unit { int pm, pn, e, aux; };
typedef int i32x8 __attribute__((ext_vector_type(8)));
__device__ __forceinline__ i32x8 cat8(bf16x8 a, bf16x8 b) { union { struct { bf16x8 x, y; } p; i32x8 v; } u; u.p.x = a; u.p.y = b; return u.v; }

template <class Op>
__device__ __forceinline__ void gemm_phase(LAS unsigned char* lds, const Op& op, int wave_) {
    constexpr int ROWB = Op::ROWB, nt = ROWB / (BK * 2);
    const int lane = lane_id_fresh(), wid = wave_, tid = wid * 64 + lane, wr = wid >> 2, wc = wid & 3, fr = lane & 15, fq = lane >> 4;
    unsigned voffB[2];
#pragma unroll
    for (int i = 0; i < 2; ++i) { int R_, C_; stage_rc(tid * 16 + i * 8192, R_, C_); voffB[i] = (unsigned)(R_ * Op::BROWB + C_ * 2); }
#define PG_AOFF(unit, o0, o1) do { const int t2_ = wid * 64 + lane_id_fresh(); int Rn_[2], Cn_[2]; stage_rc(t2_ * 16, Rn_[0], Cn_[0]); stage_rc(t2_ * 16 + 8192, Rn_[1], Cn_[1]); op.a_off(unit, Rn_, Cn_, o0, o1); } while (0)
    constexpr size_t kstep = (size_t)BK * 2, hstepB = (size_t)HALF * Op::BROWB, bstep = (size_t)Op::BKSTEP;
    const unsigned ldsw = (unsigned)wid * 1024u;
    const int aoff = lds_byte(wr * 64 + fr, fq * 8), boff = lds_byte(wc * 32 + fr, fq * 8);
#define PG_SA(b, h) (((b) * 2 + (h)) * HTB)
#define PG_SB(b, h) ((4 + (b) * 2 + (h)) * HTB)
#define PG_STAGE_A(bufoff, offs, kb) do { _Pragma("unroll") for (int _i = 0; _i < 2; ++_i) \
        __builtin_amdgcn_global_load_lds((const unsigned*)(gA + (kb) + (offs)[_i]), (LAS unsigned*)(lds + (bufoff) + ldsw + _i * 8192), 16, 0, 0); } while (0)
#define PG_STAGE_B(bufoff, gbase, kb) do { _Pragma("unroll") for (int _i = 0; _i < 2; ++_i) \
        __builtin_amdgcn_global_load_lds((const unsigned*)((gbase) + (kb) + voffB[_i]), (LAS unsigned*)(lds + (bufoff) + ldsw + _i * 8192), 16, 0, 0); } while (0)
#define PG_LD8(off) cat8(*(const LAS bf16x8*)(lds + (off)), *(const LAS bf16x8*)(lds + (off) + 1024))
#define PG_LDA(dst, b, h) do { if constexpr (Op::FP8) { _Pragma("unroll") for (int m = 0; m < 4; ++m) dst##8[m] = PG_LD8(PG_SA(b, h) + aoff + m * 2048); } \
        else { _Pragma("unroll") for (int m = 0; m < 4; ++m) _Pragma("unroll") for (int k = 0; k < 2; ++k) dst[m][k] = *(const LAS bf16x8*)(lds + PG_SA(b, h) + aoff + m * 2048 + k * 1024); } } while (0)
#define PG_LDB(dst, b, h) do { if constexpr (Op::FP8) { _Pragma("unroll") for (int n = 0; n < 2; ++n) dst##8[n] = PG_LD8(PG_SB(b, h) + boff + n * 2048); } \
        else { _Pragma("unroll") for (int n = 0; n < 2; ++n) _Pragma("unroll") for (int k = 0; k < 2; ++k) dst[n][k] = *(const LAS bf16x8*)(lds + PG_SB(b, h) + boff + n * 2048 + k * 1024); } } while (0)
#define PG_MMA(ai, bj, At, Bt) do { __builtin_amdgcn_s_setprio(1); _Pragma("unroll") for (int m = 0; m < 4; ++m) _Pragma("unroll") for (int n = 0; n < 2; ++n) { \
        if constexpr (Op::FP8) { asm volatile("v_mfma_scale_f32_16x16x128_f8f6f4 %0, %1, %2, %0, %3, %3 op_sel_hi:[0,0,0]" : "+v"(acc[ai][bj][m][n]) : "v"(Bt##8[n]), "v"(At##8[m]), "v"(sc1)); } \
        else { _Pragma("unroll") for (int k = 0; k < 2; ++k) acc[ai][bj][m][n] = __builtin_amdgcn_mfma_f32_16x16x32_bf16(Bt[n][k], At[m][k], acc[ai][bj][m][n], 0, 0, 0); } } \
        __builtin_amdgcn_s_setprio(0); } while (0)
#define PG_WAIT_V(n) asm volatile("s_waitcnt vmcnt(" #n ")" ::: "memory")
#define PG_WAIT_L(n) asm volatile("s_waitcnt lgkmcnt(" #n ")" ::: "memory")
#define PG_BAR __builtin_amdgcn_s_barrier()
#define PG_SCHED __builtin_amdgcn_sched_barrier(0)
    Unit cur, nxt; int ui = 0;
    if (!op.next(0, cur)) { op.pre_done(wid); return; }
    constexpr int TSIG = (nt > 8) ? nt - 8 : 0;
    f32x4 acc[2][2][4][2];
#pragma unroll
    for (int a = 0; a < 2; ++a)
#pragma unroll
        for (int b = 0; b < 2; ++b)
#pragma unroll
            for (int m = 0; m < 4; ++m)
#pragma unroll
                for (int n = 0; n < 2; ++n) acc[a][b][m][n] = (f32x4){0.f, 0.f, 0.f, 0.f};
    bf16x8 At[4][2], B0[2][2], B1[2][2]; i32x8 At8[4], B08[2], B18[2];
    int sc1 = 0x7f7f7f7f; asm volatile("" : "+v"(sc1));
    const char* const gA = (const char*)op.a_base();
    unsigned ca0[2], ca1[2], na0[2], na1[2];
    PG_AOFF(cur, ca0, ca1);
    const char* cB = (const char*)op.b_base(cur);
    PG_STAGE_B(PG_SB(0, 0), cB, 0); PG_STAGE_B(PG_SB(0, 1), cB + hstepB, 0); PG_STAGE_A(PG_SA(0, 0), ca0, 0); PG_STAGE_A(PG_SA(0, 1), ca1, 0);
    if (wr == 1) PG_BAR;
    PG_WAIT_V(2); PG_BAR;
    PG_STAGE_B(PG_SB(1, 0), cB, bstep); PG_STAGE_A(PG_SA(1, 0), ca0, kstep); PG_STAGE_B(PG_SB(1, 1), cB + hstepB, bstep);
    PG_WAIT_V(6); PG_BAR;
    for (;;) {
        const bool has_next = op.next(ui + 1, nxt);
        const char* nB = cB;
        if (has_next) { PG_AOFF(nxt, na0, na1); nB = (const char*)op.b_base(nxt); }
        else { na0[0] = ca0[0]; na0[1] = ca0[1]; na1[0] = ca1[0]; na1[1] = ca1[1]; }
#pragma unroll 1
        for (int t = 0; t < nt; t += 2) {
            const bool last = (t == nt - 2);
            if (t == TSIG && !has_next) op.pre_done(wid);
            const size_t k1 = (size_t)(t + 1) * kstep, k2 = last ? 0 : (size_t)(t + 2) * kstep, k3 = k2 + kstep, k2b = last ? 0 : (size_t)(t + 2) * bstep, k3b = k2b + bstep;
            const char* b2 = last ? nB : cB;
            PG_LDB(B0, 0, 0); PG_LDB(B1, 0, 1); PG_SCHED; PG_LDA(At, 0, 0); PG_STAGE_A(PG_SA(1, 1), ca1, k1);
            PG_WAIT_V(8); PG_WAIT_L(0); PG_BAR; PG_MMA(0, 0, At, B0); PG_MMA(0, 1, At, B1); PG_BAR; PG_SCHED;
            if (last) { ca0[0] = na0[0]; ca0[1] = na0[1]; ca1[0] = na1[0]; ca1[1] = na1[1]; }
            PG_LDA(At, 0, 1); PG_STAGE_B(PG_SB(0, 0), b2, k2b); PG_STAGE_B(PG_SB(0, 1), b2 + hstepB, k2b); PG_STAGE_A(PG_SA(0, 0), ca0, k2);
            PG_WAIT_V(8); PG_WAIT_L(0); PG_BAR; PG_MMA(1, 0, At, B0); PG_MMA(1, 1, At, B1); PG_BAR; PG_SCHED;
            PG_LDB(B0, 1, 0); PG_LDB(B1, 1, 1); PG_SCHED; PG_LDA(At, 1, 0); PG_STAGE_A(PG_SA(0, 1), ca1, k2);
            PG_WAIT_V(8); PG_WAIT_L(0); PG_BAR; PG_MMA(0, 0, At, B0); PG_MMA(0, 1, At, B1); PG_BAR; PG_SCHED;
            PG_LDA(At, 1, 1); PG_STAGE_B(PG_SB(1, 0), b2, k3b); PG_STAGE_B(PG_SB(1, 1), b2 + hstepB, k3b); PG_STAGE_A(PG_SA(1, 0), ca0, k3);
            PG_WAIT_V(8); PG_WAIT_L(0); PG_BAR; PG_MMA(1, 0, At, B0); PG_MMA(1, 1, At, B1); PG_BAR; PG_SCHED;
        }
        if constexpr (Op::FP8) asm volatile("s_nop 15\n\ts_nop 15\n\ts_nop 15\n\ts_nop 15" ::: "memory");
        if constexpr (Op::ALIGN) { if (wr == 0) PG_BAR; }
        { const int le_ = lane_id_fresh(); op.epi(acc, cur, wr, wc, le_ & 15, le_ >> 4); }
        if (!has_next) break;
#pragma unroll
        for (int a = 0; a < 2; ++a)
#pragma unroll
            for (int b = 0; b < 2; ++b)
#pragma unroll
                for (int m = 0; m < 4; ++m)
#pragma unroll
                    for (int n = 0; n < 2; ++n) acc[a][b][m][n] = (f32x4){0.f, 0.f, 0.f, 0.f};
        cur = nxt; cB = nB; ++ui;
        if constexpr (Op::ALIGN) { if (wr == 1) PG_BAR; }
    }
    PG_WAIT_V(0);
    if constexpr (!Op::ALIGN) { if (wr == 0) PG_BAR; }
    PG_BAR;
#undef PG_SA
#undef PG_SB
#undef PG_STAGE_A
#undef PG_STAGE_B
#undef PG_LDA
#undef PG_AOFF
#undef PG_LD8
#undef PG_LDB
#undef PG_MMA
#undef PG_WAIT_V
#undef PG_WAIT_L
#undef PG_BAR
#undef PG_SCHED
}
}


__device__ __forceinline__ void stage_store64(LAS unsigned char* slab, int fr, int fq, const f32x4 x00, const f32x4 x01, const f32x4 x10, const f32x4 x11, bf16_t* dst0, int ld) {
    LAS unsigned char* w = slab + fr * 144 + fq * 8;
    asm volatile("" ::: "memory");
    { u32x2 a; a.x = cvtpk(x00.x, x00.y); a.y = cvtpk(x00.z, x00.w); *(LAS u32x2*)(w) = a; }
    { u32x2 a; a.x = cvtpk(x01.x, x01.y); a.y = cvtpk(x01.z, x01.w); *(LAS u32x2*)(w + 32) = a; }
    { u32x2 a; a.x = cvtpk(x10.x, x10.y); a.y = cvtpk(x10.z, x10.w); *(LAS u32x2*)(w + 64) = a; }
    { u32x2 a; a.x = cvtpk(x11.x, x11.y); a.y = cvtpk(x11.z, x11.w); *(LAS u32x2*)(w + 96) = a; }
    asm volatile("" ::: "memory");
    const int lane = fq * 16 + fr, r8 = lane >> 3, p = lane & 7;
#pragma unroll
    for (int h = 0; h < 2; ++h) { const int row = r8 + 8 * h; const u32x4 v = *(const LAS u32x4*)(slab + row * 144 + p * 16); *(u32x4*)(dst0 + (size_t)row * ld + p * 8) = v; }
    asm volatile("" ::: "memory");
}
__device__ __forceinline__ void rope4(f32x4& x1, f32x4& x2, const f32x4 cs0, const f32x4 cs1) {
    const f32x4 cc = {cs0.x, cs0.z, cs1.x, cs1.z}, sn = {cs0.y, cs0.w, cs1.y, cs1.w};
    const f32x4 o1 = x1 * cc - x2 * sn, o2 = x2 * cc + x1 * sn; x1 = o1; x2 = o2;
}
template <bool F8>
struct OpIn {
    unsigned* sig = nullptr;
    __device__ __forceinline__ void pre_done(int wid) const { if (sig != nullptr && wid == 0 && lane_id_fresh() == 0) __hip_atomic_fetch_add(sig, 1u, __ATOMIC_RELAXED, __HIP_MEMORY_SCOPE_AGENT); }

    static constexpr int ROWB = F8 ? D : 2 * D, BROWB = ROWB, BKSTEP = 128; static constexpr bool FP8 = F8, ALIGN = true;
    const unsigned char* A; const unsigned char* Bt; int G, c;
    bf16_t *SQ, *SK, *SV, *RQ, *RK, *RV, *RGF, *RGB, *MQ, *CKV, *KF;
    const float* T32; const float* T16; float* SS;
    int off = 0, npn = INWP / 256, sel = 0;
    __device__ __forceinline__ bool next(int i, pg::Unit& u) const { u.e = 0; u.aux = 0; const bool ok = pg::tile_order((long)i * G + c + off, NROWS / 256, npn, u.pm, u.pn);
        if (ok) { if (sel == 1) u.pn = nth_bit(F8MASK | (F8N1 == 0), u.pn); else if (sel == 2) u.pn = nth_bit(BFMASK, u.pn); }
        return ok; }
    __device__ __forceinline__ const unsigned char* a_base() const { return A; }
    __device__ __forceinline__ void a_off(const pg::Unit& u, const int (&Rs)[2], const int (&Cs)[2], unsigned (&o0)[2], unsigned (&o1)[2]) const {
#pragma unroll
        for (int i = 0; i < 2; ++i) { o0[i] = (unsigned)((u.pm * 256 + Rs[i]) * ROWB + Cs[i] * 2); o1[i] = o0[i] + 128u * ROWB; }
    }
    __device__ __forceinline__ const unsigned char* b_base(const pg::Unit& u) const { return Bt + (size_t)u.pn * 256 * ROWB; }
    LAS unsigned char* slab;
    template <int MODE>
    __device__ __forceinline__ void epi_mode(const f32x4 (&acc)[2][2][4][2], bf16_t* dst, int ld, int col0, float scl, int part, bool isctx, int rowbase, int jbase, int wc, int fr, int fq) const {
#pragma unroll
        for (int ai = 0; ai < 2; ++ai)
#pragma unroll
            for (int m = 0; m < 4; ++m) {
                const int row0 = rowbase + ai * 128 + m * 16, j = jbase + ai * 128 + m * 16, t = j - NCTX;
                f32x4 x00 = acc[ai][0][m][0], x01 = acc[ai][0][m][1], x10 = acc[ai][1][m][0], x11 = acc[ai][1][m][1];
                if (F8) { x00 *= WSCALE_INV; x01 *= WSCALE_INV; x10 *= WSCALE_INV; x11 *= WSCALE_INV; }
                if (MODE == 1 || MODE == 2) {
                    const bool dorope = (MODE == 2) || !isctx; const int pos = (MODE == 2) ? j : (part ? (t & 63) : (t >> 6));
                    if (dorope) { const float* tab = T32 + ((size_t)pos * 32 + 4 * fq) * 2;
                        rope4(x00, x10, *(const f32x4*)tab, *(const f32x4*)(tab + 4)); rope4(x01, x11, *(const f32x4*)(tab + 32), *(const f32x4*)(tab + 36)); }
                    if (MODE == 2) { x00 *= scl; x01 *= scl; x10 *= scl; x11 *= scl; }
                } else if (MODE == 4 || MODE == 6) {
                    if (!isctx) { const float* tr_ = T16 + ((size_t)(t >> 6) * 16 + 4 * fq) * 2; const float* tc_ = T16 + ((size_t)(t & 63) * 16 + 4 * fq) * 2;
                        rope4(x00, x01, *(const f32x4*)tr_, *(const f32x4*)(tr_ + 4)); rope4(x10, x11, *(const f32x4*)tc_, *(const f32x4*)(tc_ + 4)); }
                } else if (MODE == 3) {
#pragma unroll
                    for (int e = 0; e < 4; ++e) { x00[e] = siluf(x00[e]); x01[e] = siluf(x01[e]); x10[e] = siluf(x10[e]); x11[e] = siluf(x11[e]); }
                } else if (MODE == 5) {
                    const f32x4 q = x00 * x00 + x01 * x01 + x10 * x10 + x11 * x11; float ss = (q.x + q.y) + (q.z + q.w);
                    ss += xor16_f(ss); ss = sum_xor32(ss);
                    if (fq == 0) { SS[(size_t)(row0 + fr) * 8 + wc] = ss; SS[(size_t)(row0 + fr) * 8 + 4 + wc] = 0.f; }
                }
                if (MODE == 6) {
#pragma unroll
                    for (int h = 0; h < 4; ++h) stage_store64(slab, fr, fq, x00, x01, x10, x11, dst + (size_t)row0 * 768 + h * 192 + 128, 768);
                } else stage_store64(slab, fr, fq, x00, x01, x10, x11, dst + (size_t)row0 * ld + col0, ld);
                __builtin_amdgcn_sched_barrier(0);
            }
    }
    __device__ __forceinline__ void epi(const f32x4 (&acc)[2][2][4][2], const pg::Unit& u, int wr, int wc, int fr, int fq) const {
        const int G64 = u.pn * 4 + wc;
        if (G64 >= 85) return;
        const int b = u.pm / 17, tile = u.pm - 17 * b; const bool isctx = (tile == 0);
        const int rowbase = u.pm * 256 + wr * 64, jbase = tile * 256 + wr * 64 + fr;
        if (G64 < 12)      epi_mode<1>(acc, SQ, 768, G64 * 64, 1.f, G64 & 1, isctx, rowbase, jbase, wc, fr, fq);
        else if (G64 < 16) epi_mode<1>(acc, SK, 256, (G64 - 12) * 64, 1.f, G64 & 1, isctx, rowbase, jbase, wc, fr, fq);
        else if (G64 < 20) epi_mode<0>(acc, SV, 256, (G64 - 16) * 64, 1.f, 0, isctx, rowbase, jbase, wc, fr, fq);
        else if (G64 < 26) epi_mode<2>(acc, RQ, 384, (G64 - 20) * 64, 0.125f, 0, isctx, rowbase, jbase, wc, fr, fq);
        else if (G64 < 32) epi_mode<2>(acc, RK, 384, (G64 - 26) * 64, 1.f, 0, isctx, rowbase, jbase, wc, fr, fq);
        else if (G64 < 44) epi_mode<0>(acc, RV, 768, (G64 - 32) * 64, 1.f, 0, isctx, rowbase, jbase, wc, fr, fq);
        else if (G64 < 56) epi_mode<3>(acc, RGF, 768, (G64 - 44) * 64, 1.f, 0, isctx, rowbase, jbase, wc, fr, fq);
        else if (G64 < 68) epi_mode<3>(acc, RGB, 768, (G64 - 56) * 64, 1.f, 0, isctx, rowbase, jbase, wc, fr, fq);
        else if (G64 < 80) { if ((G64 - 68) % 3 == 2) epi_mode<4>(acc, MQ, 768, (G64 - 68) * 64, 1.f, 0, isctx, rowbase, jbase, wc, fr, fq);
                             else epi_mode<0>(acc, MQ, 768, (G64 - 68) * 64, 1.f, 0, isctx, rowbase, jbase, wc, fr, fq); }
        else if (G64 < 84) epi_mode<5>(acc, CKV, 256, (G64 - 80) * 64, 1.f, 0, isctx, rowbase, jbase, wc, fr, fq);
        else               epi_mode<6>(acc, KF, 768, 128, 1.f, 0, isctx, rowbase, jbase, wc, fr, fq);
    }
};

struct OpKv {
    unsigned* sig = nullptr;
    __device__ __forceinline__ void pre_done(int wid) const { if (sig != nullptr && wid == 0 && lane_id_fresh() == 0) __hip_atomic_fetch_add(sig, 1u, __ATOMIC_RELAXED, __HIP_MEMORY_SCOPE_AGENT); }

    static constexpr int K = 256, ROWB = 512, BROWB = ROWB, BKSTEP = 128; static constexpr bool FP8 = false, ALIGN = true;
    const bf16_t* A; const bf16_t* Bt; int G, c; bf16_t* KF; bf16_t* MV; const float* SS;
    __device__ __forceinline__ bool next(int i, pg::Unit& u) const { u.e = 0; u.aux = 0; return pg::tile_order((long)i * G + c, NROWS / 256, 4, u.pm, u.pn); }
    __device__ __forceinline__ const bf16_t* a_base() const { return A; }
    __device__ __forceinline__ void a_off(const pg::Unit& u, const int (&Rs)[2], const int (&Cs)[2], unsigned (&o0)[2], unsigned (&o1)[2]) const {
#pragma unroll
        for (int i = 0; i < 2; ++i) { o0[i] = (unsigned)((u.pm * 256 + Rs[i]) * K + Cs[i]) * 2u; o1[i] = o0[i] + 128u * K * 2u; }
    }
    __device__ __forceinline__ const bf16_t* b_base(const pg::Unit& u) const { return Bt + (size_t)u.pn * 256 * K; }
    LAS unsigned char* slab;
    __device__ __forceinline__ void epi(const f32x4 (&acc)[2][2][4][2], const pg::Unit& u, int wr, int wc, int fr, int fq) const {
        const int rowbase = u.pm * 256 + wr * 64, head = (u.pn & 1) * 2 + (wc >> 1), d0 = (wc & 1) * 64;
#pragma unroll
        for (int ai = 0; ai < 2; ++ai)
#pragma unroll
            for (int m = 0; m < 4; ++m) {
                const int row0 = rowbase + ai * 128 + m * 16, row = row0 + fr;
                const f32x4 sa = *(const f32x4*)(SS + (size_t)row * 8), sb = *(const f32x4*)(SS + (size_t)row * 8 + 4);
                const float rs = __builtin_amdgcn_rsqf((((sa.x + sa.y) + (sa.z + sa.w)) + ((sb.x + sb.y) + (sb.z + sb.w))) * (1.f / 256.f) + LN_EPS);
                if (u.pn < 2) stage_store64(slab, fr, fq, acc[ai][0][m][0] * rs, acc[ai][0][m][1] * rs, acc[ai][1][m][0] * rs, acc[ai][1][m][1] * rs, KF + (size_t)row0 * 768 + head * 192 + d0, 768);
                else stage_store64(slab, fr, fq, acc[ai][0][m][0] * rs, acc[ai][0][m][1] * rs, acc[ai][1][m][0] * rs, acc[ai][1][m][1] * rs, MV + (size_t)row0 * 512 + head * 128 + d0, 512);
            }
    }
};

struct OpOut {
    unsigned* sig = nullptr;
    __device__ __forceinline__ void pre_done(int wid) const { if (sig != nullptr && wid == 0 && lane_id_fresh() == 0) __hip_atomic_fetch_add(sig, 1u, __ATOMIC_RELAXED, __HIP_MEMORY_SCOPE_AGENT); }

    static constexpr int K = D, ROWB = MK_OUT8 ? D : 2 * D, BROWB = ROWB, BKSTEP = 128; static constexpr bool FP8 = (MK_OUT8 != 0), ALIGN = true;
    const unsigned char* A; const unsigned char* Bt; int G, c; bf16_t* Y; int latent_only;
    __device__ __forceinline__ bool next(int i, pg::Unit& u) const { u.e = 0; u.aux = 0; int pm;
        const bool ok = pg::tile_order((long)i * G + c, latent_only ? 64 : 68, 8, pm, u.pn); u.pm = latent_only ? (pm >> 4) * 17 + 1 + (pm & 15) : pm; return ok; }
    __device__ __forceinline__ const unsigned char* a_base() const { return A; }
    __device__ __forceinline__ void a_off(const pg::Unit& u, const int (&Rs)[2], const int (&Cs)[2], unsigned (&o0)[2], unsigned (&o1)[2]) const {
#pragma unroll
        for (int i = 0; i < 2; ++i) { o0[i] = (unsigned)((u.pm * 256 + Rs[i]) * ROWB + Cs[i] * 2); o1[i] = o0[i] + 128u * ROWB; }
    }
    __device__ __forceinline__ const unsigned char* b_base(const pg::Unit& u) const { return Bt + (size_t)u.pn * 256 * ROWB; }
    LAS unsigned char* slab;
    __device__ __forceinline__ void epi(const f32x4 (&acc)[2][2][4][2], const pg::Unit& u, int wr, int wc, int fr, int fq) const {
        const int rowbase = u.pm * 256 + wr * 64, colbase = u.pn * 256 + 64 * wc;
#pragma unroll
        for (int ai = 0; ai < 2; ++ai)
#pragma unroll
            for (int m = 0; m < 4; ++m) { constexpr float sc_ = MK_OUT8 ? WSCALE_INV : 1.f;
                stage_store64(slab, fr, fq, acc[ai][0][m][0] * sc_, acc[ai][0][m][1] * sc_, acc[ai][1][m][0] * sc_, acc[ai][1][m][1] * sc_, Y + (size_t)(rowbase + ai * 128 + m * 16) * D + colbase, D); }
    }
};

struct MoeTab { const LAS int* cnt; const LAS int* tstart; const LAS unsigned char* tile_e; int T; };
__device__ __forceinline__ MoeTab moe_tables(const Frame& F, int l) {
    LAS int* cnt = (LAS int*)(F.lds + MISC_OFF + 64); LAS int* tstart = cnt + 32; LAS unsigned char* tile_e = (LAS unsigned char*)(tstart + 40);
    __syncthreads();
    if (F.tid < 32) cnt[F.tid] = (int)__hip_atomic_load(F.ctl + CW_CNT + 64 * l + F.tid, __ATOMIC_RELAXED, __HIP_MEMORY_SCOPE_AGENT);
    __syncthreads();
    if (F.tid == 0) { int s = 0; for (int e = 0; e < 32; ++e) { tstart[e] = s; s += (cnt[e] + 255) >> 8; } tstart[32] = s; }
    __syncthreads();
    const int T = tstart[32];
    for (int t = F.tid; t < T; t += NTHREADS) { int e = 0; while (tstart[e + 1] <= t) ++e; tile_e[t] = (unsigned char)e; }
    __syncthreads();
    MoeTab m; m.cnt = cnt; m.tstart = tstart; m.tile_e = tile_e; m.T = T; return m;
}

struct OpMoe1 {
    unsigned* sig = nullptr;
    __device__ __forceinline__ void pre_done(int wid) const { if (sig != nullptr && wid == 0 && lane_id_fresh() == 0) __hip_atomic_fetch_add(sig, 1u, __ATOMIC_RELAXED, __HIP_MEMORY_SCOPE_AGENT); }

    static constexpr int ROWB = D, BROWB = 128, BKSTEP = 256 * 128; static constexpr bool FP8 = true, ALIGN = true;
    const unsigned char* A; const unsigned char* Bt; int G, c; MoeTab tb; const int* LISTE; unsigned char* ACT;
    __device__ __forceinline__ bool next(int i, pg::Unit& u) const {
        const long L = (long)i * G + c; const int nwg = tb.T * 8; if (L >= nwg) return false;
        int wgid = (int)L; { const int q = nwg / 8, r = nwg % 8, xcd = wgid % 8, off = wgid / 8; wgid = (xcd < r ? xcd * (q + 1) : r * (q + 1) + (xcd - r) * q) + off; }
        const int ti = wgid >> 3; u.pn = wgid & 7; u.e = tb.tile_e[ti]; u.pm = ti; u.aux = ti - tb.tstart[u.e]; return true;
    }
    __device__ __forceinline__ const unsigned char* a_base() const { return A; }
    __device__ __forceinline__ void a_off(const pg::Unit& u, const int (&Rs)[2], const int (&Cs)[2], unsigned (&o0)[2], unsigned (&o1)[2]) const {
        const int n = tb.cnt[u.e]; const int* lst = LISTE + (size_t)u.e * NAID;
#pragma unroll
        for (int i = 0; i < 2; ++i) {
            const int p0 = u.aux * 256 + Rs[i], p1 = p0 + 128;
            const int r0 = (p0 < n) ? (lst[p0] >> 1) : 0, r1 = (p1 < n) ? (lst[p1] >> 1) : 0;
            o0[i] = (unsigned)(r0 * ROWB + Cs[i] * 2); o1[i] = (unsigned)(r1 * ROWB + Cs[i] * 2); }
    }
    __device__ __forceinline__ const unsigned char* b_base(const pg::Unit& u) const { return Bt + ((size_t)u.e * 2048 + (size_t)u.pn * 256) * ROWB; }
    __device__ __forceinline__ void epi(const f32x4 (&acc)[2][2][4][2], const pg::Unit& u, int wr, int wc, int fr, int fq) const {
        const int rowbase = u.pm * 256 + wr * 64 + fr, colbase = u.pn * 128 + 16 * wc + 4 * fq;
#pragma unroll
        for (int ai = 0; ai < 2; ++ai)
#pragma unroll
            for (int m = 0; m < 4; ++m) { unsigned char* p = ACT + (size_t)(rowbase + ai * 128 + m * 16) * EH + colbase;
#pragma unroll
                for (int bj = 0; bj < 2; ++bj) { const f32x4 g = acc[ai][bj][m][0] * WSCALE_INV, uu = acc[ai][bj][m][1] * WSCALE_INV; f32x4 o;
#pragma unroll
                    for (int e = 0; e < 4; ++e) o[e] = siluf(g[e]) * uu[e];
                    *(unsigned*)(p + bj * 64) = pk_fp8x4(o.x, o.y, o.z, o.w); } }
    }
};
struct OpMoe2 {
    unsigned* sig = nullptr;
    __device__ __forceinline__ void pre_done(int wid) const { if (sig != nullptr && wid == 0 && lane_id_fresh() == 0) __hip_atomic_fetch_add(sig, 1u, __ATOMIC_RELAXED, __HIP_MEMORY_SCOPE_AGENT); }

    static constexpr int ROWB = EH, BROWB = 128, BKSTEP = 256 * 128; static constexpr bool FP8 = true, ALIGN = true;
    const unsigned char* A; const unsigned char* Bt; int G, c; MoeTab tb; const int* LISTE; const float* AW; unsigned char* F2;
    __device__ __forceinline__ bool next(int i, pg::Unit& u) const {
        const long L = (long)i * G + c; const int nwg = tb.T * 8; if (L >= nwg) return false;
        int wgid = (int)L; { const int q = nwg / 8, r = nwg % 8, xcd = wgid % 8, off = wgid / 8; wgid = (xcd < r ? xcd * (q + 1) : r * (q + 1) + (xcd - r) * q) + off; }
        const int ti = wgid >> 3; u.pn = wgid & 7; u.e = tb.tile_e[ti]; u.pm = ti; u.aux = ti - tb.tstart[u.e]; return true;
    }
    __device__ __forceinline__ const unsigned char* a_base() const { return A; }
    __device__ __forceinline__ void a_off(const pg::Unit& u, const int (&Rs)[2], const int (&Cs)[2], unsigned (&o0)[2], unsigned (&o1)[2]) const {
#pragma unroll
        for (int i = 0; i < 2; ++i) { o0[i] = (unsigned)((u.pm * 256 + Rs[i]) * ROWB + Cs[i] * 2); o1[i] = o0[i] + 128u * ROWB; }
    }
    __device__ __forceinline__ const unsigned char* b_base(const pg::Unit& u) const { return Bt + ((size_t)u.e * 2048 + (size_t)u.pn * 256) * ROWB; }
    __device__ __forceinline__ void epi(const f32x4 (&acc)[2][2][4][2], const pg::Unit& u, int wr, int wc, int fr, int fq) const {
        const int n = tb.cnt[u.e]; const int* lst = LISTE + (size_t)u.e * NAID; const int colbase = u.pn * 256 + 32 * wc + 4 * fq;
        int aid[2][4]; float w[2][4];
#pragma unroll
        for (int ai = 0; ai < 2; ++ai)
#pragma unroll
            for (int m = 0; m < 4; ++m) { const int pos = u.aux * 256 + ai * 128 + wr * 64 + m * 16 + fr; aid[ai][m] = (pos < n) ? lst[pos] : -1;
                w[ai][m] = (pos < n) ? AW[(size_t)u.e * NAID + pos] * (WSCALE_INV * F2SCALE) : 0.f; }
#pragma unroll
        for (int ai = 0; ai < 2; ++ai)
#pragma unroll
            for (int m = 0; m < 4; ++m) {
                if (aid[ai][m] >= 0) { unsigned char* p = F2 + (size_t)aid[ai][m] * D + colbase; const float ww = w[ai][m];
#pragma unroll
                    for (int bj = 0; bj < 2; ++bj) { const f32x4 v0 = acc[ai][bj][m][0] * ww, v1 = acc[ai][bj][m][1] * ww;
                        *(unsigned*)(p + bj * 128) = pk_fp8x4(v0.x, v0.y, v0.z, v0.w); *(unsigned*)(p + bj * 128 + 16) = pk_fp8x4(v1.x, v1.y, v1.z, v1.w); } } }
    }
};

namespace att {
constexpr int V_BYTES = 16384, KM_BYTES = 16384, KR_BYTES = 8192;
constexpr int OFF_V = 0, OFF_KM = 2 * V_BYTES, OFF_KR = OFF_KM + 2 * KM_BYTES, OFF_WS = OFF_KR + 2 * KR_BYTES, LDS_TOTAL = OFF_WS + 8 * 256;
__device__ __forceinline__ int crow(int r, int hi) { return (r & 3) + 8 * (r >> 2) + 4 * hi; }
__device__ __forceinline__ int v_st(int k, int c) { const int kk = (k & ~0xC) | ((k & 4) << 1) | ((k & 8) >> 1); return ((kk >> 3) * 4 + (c >> 5)) * 512 + ((kk & 7) * 32 + (c & 31)) * 2; }
__device__ __forceinline__ int v_rd_base(int lane) { return ((lane & 3) << 3) | (((lane >> 2) & 3) << 6) | (((lane >> 4) & 1) << 5) | (((lane >> 5) & 1) << 8); }
constexpr int v_rd_off(int d0, int ks, int half) { return d0 * 512 + ks * 4096 + half * 2048; }
template <int OFF> __device__ __forceinline__ s16x4 tr_read(unsigned vb) { s16x4 r; asm volatile("ds_read_b64_tr_b16 %0, %1 offset:%2" : "=&v"(r) : "v"(vb), "i"(OFF) : "memory"); return r; }
#define ATT_PK(L, H) (bf16x8){L[0], L[1], L[2], L[3], H[0], H[1], H[2], H[3]}
template <int D0> __device__ __forceinline__ void pv_issue(unsigned vb, s16x4 (&l)[4], s16x4 (&h)[4]) {
    l[0] = tr_read<v_rd_off(D0, 0, 0)>(vb); h[0] = tr_read<v_rd_off(D0, 0, 1)>(vb); l[1] = tr_read<v_rd_off(D0, 1, 0)>(vb); h[1] = tr_read<v_rd_off(D0, 1, 1)>(vb);
    l[2] = tr_read<v_rd_off(D0, 2, 0)>(vb); h[2] = tr_read<v_rd_off(D0, 2, 1)>(vb); l[3] = tr_read<v_rd_off(D0, 3, 0)>(vb); h[3] = tr_read<v_rd_off(D0, 3, 1)>(vb);
}
__device__ __forceinline__ void pv_mma(f32x16& od, const s16x4 (&l)[4], const s16x4 (&h)[4], bf16x8 pa0, bf16x8 pa1, bf16x8 pa2, bf16x8 pa3) {
    od = __builtin_amdgcn_mfma_f32_32x32x16_bf16(pa0, ATT_PK(l[0], h[0]), od, 0, 0, 0);
    od = __builtin_amdgcn_mfma_f32_32x32x16_bf16(pa1, ATT_PK(l[1], h[1]), od, 0, 0, 0);
    od = __builtin_amdgcn_mfma_f32_32x32x16_bf16(pa2, ATT_PK(l[2], h[2]), od, 0, 0, 0);
    od = __builtin_amdgcn_mfma_f32_32x32x16_bf16(pa3, ATT_PK(l[3], h[3]), od, 0, 0, 0);
}

__device__ __forceinline__ void partialSM(f32x16& p0, f32x16& p1, float& m_reg, float& mn, float& alpha, float C, float thr_raw) {
    float pmax = p0[0];
#pragma unroll
    for (int r = 1; r < 16; ++r) pmax = fmaxf(pmax, p0[r]);
#pragma unroll
    for (int r = 0; r < 16; ++r) pmax = fmaxf(pmax, p1[r]);
    { auto sw = __builtin_amdgcn_permlane32_swap(__float_as_uint(pmax), __float_as_uint(pmax), false, false); pmax = fmaxf(__uint_as_float(sw[0]), __uint_as_float(sw[1])); }
    if (__builtin_expect(__all(pmax - m_reg <= thr_raw), 1)) { mn = m_reg; alpha = 1.f; }
    else { mn = fmaxf(m_reg, pmax); alpha = __builtin_amdgcn_exp2f((m_reg - mn) * C); m_reg = mn; }
    const float mnC = -mn * C;
#pragma unroll
    for (int r = 0; r < 16; ++r) { p0[r] = fmaf(p0[r], C, mnC); p1[r] = fmaf(p1[r], C, mnC); }
#pragma unroll
    for (int r = 0; r < 16; ++r) p0[r] = __builtin_amdgcn_exp2f(p0[r]);
}
__device__ __forceinline__ void finishSM(f32x16& p0, f32x16& p1, float alpha, float& l_reg, bf16x8& pa0, bf16x8& pa1, bf16x8& pa2, bf16x8& pa3) {
#pragma unroll
    for (int r = 0; r < 16; ++r) p1[r] = __builtin_amdgcn_exp2f(p1[r]);
    float ps = 0.f;
#pragma unroll
    for (int r = 0; r < 16; ++r) ps += p0[r];
#pragma unroll
    for (int r = 0; r < 16; ++r) ps += p1[r];
    { auto sw = __builtin_amdgcn_permlane32_swap(__float_as_uint(ps), __float_as_uint(ps), false, false); ps = __uint_as_float(sw[0]) + __uint_as_float(sw[1]); }
    l_reg = l_reg * alpha + ps;
#define ATT_PK4(P, BASE, OUT) do { const unsigned a0 = cvtpk(P[BASE + 0], P[BASE + 1]), a1 = cvtpk(P[BASE + 2], P[BASE + 3]); \
        const unsigned b0 = cvtpk(P[BASE + 4], P[BASE + 5]), b1 = cvtpk(P[BASE + 6], P[BASE + 7]); \
        auto r0 = __builtin_amdgcn_permlane32_swap(a0, b0, false, false); auto r1 = __builtin_amdgcn_permlane32_swap(a1, b1, false, false); \
        u32x4 w = {r0[0], r1[0], r0[1], r1[1]}; OUT = *reinterpret_cast<bf16x8*>(&w); } while (0)
    ATT_PK4(p0, 0, pa0); ATT_PK4(p0, 8, pa1); ATT_PK4(p1, 0, pa2); ATT_PK4(p1, 8, pa3);
#undef ATT_PK4
}
template <int DQK>
__device__ __forceinline__ void qkt(f32x16& p0, f32x16& p1, const LAS unsigned char* Km, const LAS unsigned char* Kr, const bf16x8* qr, int r32, int hi) {
#pragma unroll
    for (int r = 0; r < 16; ++r) { p0[r] = 0.f; p1[r] = 0.f; }
#pragma unroll
    for (int d0 = 0; d0 < 8; ++d0) { const int ch = 2 * d0 + hi;
        const bf16x8 b0 = *(const LAS bf16x8*)(Km + r32 * 256 + ((ch ^ (r32 & 15)) << 4));
        const bf16x8 b1 = *(const LAS bf16x8*)(Km + (32 + r32) * 256 + ((ch ^ (r32 & 15)) << 4));
        p0 = __builtin_amdgcn_mfma_f32_32x32x16_bf16(b0, qr[d0], p0, 0, 0, 0);
        p1 = __builtin_amdgcn_mfma_f32_32x32x16_bf16(b1, qr[d0], p1, 0, 0, 0); }
    if (DQK == 192) {
#pragma unroll
        for (int d0 = 8; d0 < DQK / 16; ++d0) { const int ch = 2 * (d0 - 8) + hi;
            const bf16x8 b0 = *(const LAS bf16x8*)(Kr + r32 * 128 + ((ch ^ ((r32 >> 1) & 7)) << 4));
            const bf16x8 b1 = *(const LAS bf16x8*)(Kr + (32 + r32) * 128 + ((ch ^ ((r32 >> 1) & 7)) << 4));
            p0 = __builtin_amdgcn_mfma_f32_32x32x16_bf16(b0, qr[d0], p0, 0, 0, 0);
            p1 = __builtin_amdgcn_mfma_f32_32x32x16_bf16(b1, qr[d0], p1, 0, 0, 0); }
    }
}
__device__ __forceinline__ void pv_tile(f32x16 (&o)[4], unsigned vb, bf16x8 pa0, bf16x8 pa1, bf16x8 pa2, bf16x8 pa3) {
    s16x4 vl0[4], vh0[4], vl1[4], vh1[4];
    pv_issue<0>(vb, vl0, vh0); pv_issue<1>(vb, vl1, vh1);
    asm volatile("s_waitcnt lgkmcnt(0)" ::: "memory"); __builtin_amdgcn_sched_barrier(0);
    pv_mma(o[0], vl0, vh0, pa0, pa1, pa2, pa3); pv_mma(o[1], vl1, vh1, pa0, pa1, pa2, pa3);
    pv_issue<2>(vb, vl0, vh0); pv_issue<3>(vb, vl1, vh1);
    asm volatile("s_waitcnt lgkmcnt(0)" ::: "memory"); __builtin_amdgcn_sched_barrier(0);
    pv_mma(o[2], vl0, vh0, pa0, pa1, pa2, pa3); pv_mma(o[3], vl1, vh1, pa0, pa1, pa2, pa3);
}

template <int DQK, bool WIN>
__device__ __forceinline__ void attn_unit(const bf16_t* __restrict__ Qp, int ldq, const bf16_t* __restrict__ Kp, int ldk, const bf16_t* __restrict__ Vp, int ldv, bf16_t* __restrict__ Op, int ldo,
                                          int nA, int nB, int kB0, int tq0, int tkB0, float m_init, float l_init, float C, float thr_raw, LAS unsigned char* lds, int wave_) {
    constexpr int ND = DQK / 16;
    const int lane = lane_id_fresh(), wid = wave_, r32 = lane & 31, hi = lane >> 5;
    LAS float* wsf = (LAS float*)(lds + OFF_WS) + wid * 64; LAS float* li_l = wsf; LAS float* al_l = wsf + 32;
    float m_reg = m_init, l_reg = l_init;
    f32x16 o[4];
#pragma unroll
    for (int d = 0; d < 4; ++d)
#pragma unroll
        for (int r = 0; r < 16; ++r) o[d][r] = 0.f;
    bf16x8 qr[ND];
    const bf16_t* Qw = Qp + (size_t)(wid * 32 + r32) * ldq + hi * 8;
#pragma unroll
    for (int d0 = 0; d0 < ND; ++d0) qr[d0] = *(const bf16x8*)(Qw + d0 * 16);
    unsigned okm[2], ov[2], okr;
#pragma unroll
    for (int i = 0; i < 2; ++i) { const int s_ = (2 * wid + i) * 64 + lane, row = s_ >> 4, lc = (s_ & 15) ^ (row & 15); okm[i] = (unsigned)(row * ldk + lc * 8) * 2u;
        const int sub = s_ >> 5, kk = ((sub >> 2) << 3) | ((s_ & 31) >> 2), key = (kk & ~0xC) | ((kk & 4) << 1) | ((kk & 8) >> 1), col = (sub & 3) * 32 + (s_ & 3) * 8;
        ov[i] = (unsigned)(key * ldv + col) * 2u; }
    { const int s_ = wid * 64 + lane, row = s_ >> 3, lc = (s_ & 7) ^ ((row >> 1) & 7); okr = (unsigned)(row * ldk + 128 + lc * 8) * 2u; }
    const unsigned vb0 = (unsigned)(size_t)(lds + OFF_V) + (unsigned)v_rd_base(lane);
    const int NT = nA + nB;
#define ATT_KROW(t) (((t) < nA) ? (t) * 64 : kB0 + ((t) - nA) * 64)
#define ATT_STAGE_K(t, b) do { const char* kg_ = (const char*)(Kp + (size_t)ATT_KROW(t) * ldk); \
        _Pragma("unroll") for (int i_ = 0; i_ < 2; ++i_) __builtin_amdgcn_global_load_lds((const unsigned*)(kg_ + okm[i_]), (LAS unsigned*)(lds + OFF_KM + (b) * KM_BYTES + (2 * wid + i_) * 1024), 16, 0, 0); \
        if (DQK == 192) __builtin_amdgcn_global_load_lds((const unsigned*)(kg_ + okr), (LAS unsigned*)(lds + OFF_KR + (b) * KR_BYTES + wid * 1024), 16, 0, 0); } while (0)
#define ATT_STAGE_V(t, b) do { const char* vg_ = (const char*)(Vp + (size_t)ATT_KROW(t) * ldv); \
        _Pragma("unroll") for (int i_ = 0; i_ < 2; ++i_) __builtin_amdgcn_global_load_lds((const unsigned*)(vg_ + ov[i_]), (LAS unsigned*)(lds + OFF_V + (b) * V_BYTES + (2 * wid + i_) * 1024), 16, 0, 0); } while (0)
#define ATT_QKT(P0, P1, t) qkt<DQK>(P0, P1, lds + OFF_KM + ((t) & 1) * KM_BYTES, lds + OFF_KR + ((t) & 1) * KR_BYTES, qr, r32, hi)
#define ATT_MASK(P0, P1, t) do { if (WIN && (t) >= nA) { const int dk_ = tkB0 + ((t) - nA) * 64 - (tq0 + wid * 32 + r32); \
        _Pragma("unroll") for (int r = 0; r < 16; ++r) { const int d0_ = dk_ + crow(r, hi), d1_ = d0_ + 32; \
            P0[r] = (d0_ >= -128 && d0_ <= 128) ? P0[r] : -1e30f; P1[r] = (d1_ >= -128 && d1_ <= 128) ? P1[r] : -1e30f; } } } while (0)
#define ATT_RESC(a) do { if (__any((a) < 1.f)) { if (hi == 0) al_l[r32] = (a); LDS_WAIT(); \
        _Pragma("unroll") for (int r = 0; r < 16; ++r) { const float a_ = al_l[crow(r, hi)]; _Pragma("unroll") for (int d = 0; d < 4; ++d) o[d][r] *= a_; } } } while (0)
#define ATT_SBAR() __builtin_amdgcn_sched_barrier(0)
    f32x16 pA0, pA1, pB0, pB1; float mnA, mnB, alA, alB; bf16x8 pa0, pa1, pa2, pa3;
    __syncthreads();
    ATT_STAGE_K(0, 0); VM_WAIT(); __syncthreads();
    ATT_STAGE_K(1, 1); ATT_STAGE_V(0, 0);
    ATT_QKT(pA0, pA1, 0); ATT_MASK(pA0, pA1, 0); partialSM(pA0, pA1, m_reg, mnA, alA, C, thr_raw);
    VM_WAIT(); __syncthreads();
    for (int j = 1; j + 1 < NT; j += 2) {
        ATT_STAGE_K(j + 1, 0); ATT_STAGE_V(j, 1);
        ATT_SBAR(); ATT_QKT(pB0, pB1, j); finishSM(pA0, pA1, alA, l_reg, pa0, pa1, pa2, pa3); ATT_SBAR();
        ATT_MASK(pB0, pB1, j);
        pv_tile(o, vb0, pa0, pa1, pa2, pa3); partialSM(pB0, pB1, m_reg, mnB, alB, C, thr_raw);
        VM_WAIT(); __syncthreads(); ATT_RESC(alB);
        ATT_STAGE_K(j + 2, 1); ATT_STAGE_V(j + 1, 0);
        ATT_SBAR(); ATT_QKT(pA0, pA1, j + 1); finishSM(pB0, pB1, alB, l_reg, pa0, pa1, pa2, pa3); ATT_SBAR();
        ATT_MASK(pA0, pA1, j + 1);
        pv_tile(o, vb0 + (unsigned)V_BYTES, pa0, pa1, pa2, pa3); partialSM(pA0, pA1, m_reg, mnA, alA, C, thr_raw);
        VM_WAIT(); __syncthreads(); ATT_RESC(alA);
    }
    ATT_STAGE_V(NT - 1, 1);
    ATT_SBAR(); ATT_QKT(pB0, pB1, NT - 1); finishSM(pA0, pA1, alA, l_reg, pa0, pa1, pa2, pa3); ATT_SBAR();
    ATT_MASK(pB0, pB1, NT - 1);
    pv_tile(o, vb0, pa0, pa1, pa2, pa3); partialSM(pB0, pB1, m_reg, mnB, alB, C, thr_raw);
    VM_WAIT(); __syncthreads(); ATT_RESC(alB);
    finishSM(pB0, pB1, alB, l_reg, pa0, pa1, pa2, pa3); ATT_SBAR();
    pv_tile(o, vb0 + (unsigned)V_BYTES, pa0, pa1, pa2, pa3);
    if (hi == 0) li_l[r32] = l_reg;
    LDS_WAIT();
    bf16_t* Ow = Op + (size_t)(wid * 32) * ldo;
    if (MK_OUT8) {
        unsigned char* O8 = (unsigned char*)Op + (size_t)(wid * 32) * ldo + (r32 & ~3);
        const int q_ = r32 & 3; const bool b_ = (q_ & 1) != 0, c_ = (q_ & 2) != 0;
#pragma unroll
        for (int g = 0; g < 4; ++g) {
            const int rowq = q_ + 8 * g + 4 * hi;
            const float l0 = __builtin_amdgcn_rcpf(li_l[8 * g + 4 * hi]), l1 = __builtin_amdgcn_rcpf(li_l[8 * g + 4 * hi + 1]), l2 = __builtin_amdgcn_rcpf(li_l[8 * g + 4 * hi + 2]), l3 = __builtin_amdgcn_rcpf(li_l[8 * g + 4 * hi + 3]);
#pragma unroll
            for (int d0 = 0; d0 < 4; ++d0) {
                const float x0 = o[d0][4 * g] * l0, x1 = o[d0][4 * g + 1] * l1, x2 = o[d0][4 * g + 2] * l2, x3 = o[d0][4 * g + 3] * l3;
                const float r0 = dpp_f<0xB1>(b_ ? x0 : x1), r1 = dpp_f<0xB1>(b_ ? x2 : x3);
                const float Alo = b_ ? r0 : x0, Ahi = b_ ? x1 : r0, Blo = b_ ? r1 : x2, Bhi = b_ ? x3 : r1;
                const float s0 = dpp_f<0x4E>(c_ ? Alo : Blo), s1 = dpp_f<0x4E>(c_ ? Ahi : Bhi);
                const float Klo = c_ ? Blo : Alo, Khi = c_ ? Bhi : Ahi;
                const unsigned w = c_ ? pk_fp8x4(s0, s1, Klo, Khi) : pk_fp8x4(Klo, Khi, s0, s1);
                *(unsigned*)(O8 + (size_t)rowq * ldo + d0 * 32) = w; } }
    } else {
#pragma unroll
    for (int r = 0; r < 16; ++r) { const int orow = crow(r, hi); const float rl = __builtin_amdgcn_rcpf(li_l[orow]);
#pragma unroll
        for (int d0 = 0; d0 < 4; ++d0) Ow[(size_t)orow * ldo + d0 * 32 + r32] = (bf16_t)(cvtpk(o[d0][r] * rl, 0.f) & 0xffffu); }
    }
#undef ATT_KROW
#undef ATT_STAGE_K
#undef ATT_STAGE_V
#undef ATT_QKT
#undef ATT_MASK
#undef ATT_RESC
#undef ATT_SBAR
}
}

namespace ret {
__device__ __forceinline__ int bwd_chunk_of_block(int blk) { return blk == 1 ? 0 : (blk == 0 ? 1 : 35 - blk); }
__device__ __forceinline__ float log2_gamma(const float* ret_decay, int l, int dir, int h) { const float p = ret_decay[(l * 2 + dir) * 6 + h]; return __log2f(1.f - exp2f(-p)); }
__device__ __forceinline__ s16x4 tr16(unsigned addr) { s16x4 r; asm volatile("ds_read_b64_tr_b16 %0, %1" : "=&v"(r) : "v"(addr) : "memory"); return r; }
__device__ __forceinline__ void tr_frag_issue(unsigned base, int S, int ks, int col0, int lane, s16x4& lo, s16x4& hi) {
    const int g = lane >> 4, q = (lane & 15) >> 2, p = lane & 3;
    const unsigned a = base + (unsigned)((32 * ks + 8 * g + q) * S + (col0 + 4 * p) * 2);
    lo = tr16(a); hi = tr16(a + 4u * (unsigned)S);
}
#define RET_PK(L, H) (bf16x8){L[0], L[1], L[2], L[3], H[0], H[1], H[2], H[3]}
constexpr int SV = 272, SK = 144;

__device__ __forceinline__ int chain_block(int dir, int n) { return dir ? (n == 0 ? 1 : (n == 1 ? 0 : 35 - n)) : n; }
__device__ __forceinline__ void chain_unit(const Frame& F, const Params& P, int l, int u) {
    const int dir = u / 24, b = (u % 24) / 6, h = u % 6;
    const bf16_t* RK = (const bf16_t*)(F.ws + WS_RK); const bf16_t* RV = (const bf16_t*)(F.ws + WS_RV); bf16_t* SP = (bf16_t*)(F.ws + WS_SPREV);
    const float lg = log2_gamma(P.in[I_RDEC], l, dir, h), dec = __builtin_amdgcn_exp2f(128.f * lg);
    constexpr int BUFB = 128 * SK + 128 * SV;
    const int g = F.lane >> 4, l16 = F.lane & 15, dv0 = 16 * F.wave;
    f32x4 acc[4];
#pragma unroll
    for (int n = 0; n < 4; ++n) acc[n] = (f32x4){0.f, 0.f, 0.f, 0.f};
    u32x4 kreg[2], vreg[4];
#define CH_LOAD(n_) do { const int r0_ = b * TPB + chain_block(dir, (n_)) * 128; \
        _Pragma("unroll") for (int i = 0; i < 2; ++i) { const int c = F.tid + 512 * i; kreg[i] = *(const u32x4*)(RK + (size_t)(r0_ + (c >> 3)) * 384 + h * 64 + (c & 7) * 8); } \
        _Pragma("unroll") for (int i = 0; i < 4; ++i) { const int c = F.tid + 512 * i; vreg[i] = *(const u32x4*)(RV + (size_t)(r0_ + (c >> 4)) * 768 + h * 128 + (c & 15) * 8); } } while (0)
#define CH_WRITE(buf_) do { LAS unsigned char* kb_ = F.lds + (buf_) * BUFB; LAS unsigned char* vb_ = kb_ + 128 * SK; \
        _Pragma("unroll") for (int i = 0; i < 2; ++i) { const int c = F.tid + 512 * i, row = c >> 3, ch = c & 7; \
            const float w_ = __builtin_amdgcn_exp2f(lg * (float)(dir ? row : 127 - row)); u32x4 o_; \
            _Pragma("unroll") for (int e = 0; e < 4; ++e) o_[e] = cvtpk(bflo(kreg[i][e]) * w_, bfhi(kreg[i][e]) * w_); \
            *(LAS u32x4*)(kb_ + row * SK + ch * 16) = o_; } \
        _Pragma("unroll") for (int i = 0; i < 4; ++i) { const int c = F.tid + 512 * i; *(LAS u32x4*)(vb_ + (c >> 4) * SV + (c & 15) * 16) = vreg[i]; } } while (0)
    __syncthreads();
    CH_LOAD(0); CH_WRITE(0); __syncthreads();
#pragma unroll 1
    for (int n = 0; n < 34; ++n) {
        if (n + 1 < 34) CH_LOAD(n + 1);
        bf16_t* dst = SP + ((size_t)u * 34 + n) * 8192;
#pragma unroll
        for (int n4 = 0; n4 < 4; ++n4) {
#pragma unroll
            for (int rg = 0; rg < 4; ++rg) dst[(dv0 + 4 * g + rg) * 64 + 16 * n4 + l16] = (bf16_t)(cvtpk(acc[n4][rg], 0.f) & 0xffffu);
            acc[n4] *= dec; }
        const unsigned kbase = (unsigned)(size_t)(F.lds + (n & 1) * BUFB), vbase = kbase + 128 * SK;
        {
            s16x4 al[4], ah[4], fl[4][4], fh[4][4];
#pragma unroll
            for (int ks = 0; ks < 4; ++ks) { tr_frag_issue(vbase, SV, ks, dv0, F.lane, al[ks], ah[ks]);
#pragma unroll
                for (int n4 = 0; n4 < 4; ++n4) tr_frag_issue(kbase, SK, ks, 16 * n4, F.lane, fl[ks][n4], fh[ks][n4]); }
            asm volatile("s_waitcnt lgkmcnt(0)" ::: "memory"); __builtin_amdgcn_sched_barrier(0);
#pragma unroll
            for (int ks = 0; ks < 4; ++ks) { const bf16x8 a = RET_PK(al[ks], ah[ks]);
#pragma unroll
                for (int n4 = 0; n4 < 4; ++n4) acc[n4] = __builtin_amdgcn_mfma_f32_16x16x32_bf16(a, RET_PK(fl[ks][n4], fh[ks][n4]), acc[n4], 0, 0, 0); }
        }
        if (n + 1 < 34) CH_WRITE((n + 1) & 1);
        __syncthreads();
    }
#undef CH_LOAD
#undef CH_WRITE
}

__device__ __forceinline__ void rc_unit(const Frame& F, const Params& P, int l, int u) {
    const int b = u / (6 * 34), rem = u % (6 * 34), h = rem / 34, blk = rem % 34;
    const bf16_t* RQ = (const bf16_t*)(F.ws + WS_RQ); const bf16_t* RK = (const bf16_t*)(F.ws + WS_RK); const bf16_t* RV = (const bf16_t*)(F.ws + WS_RV);
    const bf16_t* RGF = (const bf16_t*)(F.ws + WS_RGF); const bf16_t* RGB = (const bf16_t*)(F.ws + WS_RGB); const bf16_t* SP = (const bf16_t*)(F.ws + WS_SPREV);
    bf16_t* MIX = (bf16_t*)(F.ws + WS_MIX);
    const int r0 = b * TPB + blk * 128;
    const float lgf = log2_gamma(P.in[I_RDEC], l, 0, h), lgb = log2_gamma(P.in[I_RDEC], l, 1, h);
    LAS unsigned char* Vl = F.lds; LAS unsigned char* Pf = F.lds + 128 * SV + F.wave * (2 * 16 * SV); LAS unsigned char* Pb = Pf + 16 * SV;
    const int g = F.lane >> 4, l16 = F.lane & 15, q0 = 16 * F.wave;
    __syncthreads();
#pragma unroll
    for (int i = 0; i < 4; ++i) { const int c = F.tid + 512 * i, row = c >> 4, ch = c & 15;
        *(LAS u32x4*)(Vl + row * SV + ch * 16) = *(const u32x4*)(RV + (size_t)(r0 + row) * 768 + h * 128 + ch * 8); }
    __syncthreads();
    bf16x8 qf[2];
#pragma unroll
    for (int ks = 0; ks < 2; ++ks) qf[ks] = *(const bf16x8*)(RQ + (size_t)(r0 + q0 + l16) * 384 + h * 64 + 32 * ks + 8 * g);
    f32x4 acc[2][8];
#pragma unroll
    for (int d = 0; d < 2; ++d)
#pragma unroll
        for (int n = 0; n < 8; ++n) acc[d][n] = (f32x4){0.f, 0.f, 0.f, 0.f};
#pragma unroll
    for (int d = 0; d < 2; ++d) { const int chunk = d ? bwd_chunk_of_block(blk) : blk;
        const bf16_t* st = SP + ((((size_t)d * 4 + b) * 6 + h) * 34 + chunk) * 8192 + l16 * 64 + 8 * g;
        bf16x8 sf[8][2];
#pragma unroll
        for (int n = 0; n < 8; ++n)
#pragma unroll
            for (int ks = 0; ks < 2; ++ks) sf[n][ks] = *(const bf16x8*)(st + n * 1024 + 32 * ks);
#pragma unroll
        for (int n = 0; n < 8; ++n)
#pragma unroll
            for (int ks = 0; ks < 2; ++ks) acc[d][n] = __builtin_amdgcn_mfma_f32_16x16x32_bf16(sf[n][ks], qf[ks], acc[d][n], 0, 0, 0);
        __builtin_amdgcn_sched_barrier(0); }
    {
        const int i = q0 + l16; const float ff = __builtin_amdgcn_exp2f(lgf * (float)(i + 1)), fb = __builtin_amdgcn_exp2f(lgb * (float)(128 - i));
#pragma unroll
        for (int n = 0; n < 8; ++n) { acc[0][n] *= ff; acc[1][n] *= fb; }
    }
    {
        const int i = q0 + l16;
        const bf16_t* kp = RK + (size_t)(r0 + l16) * 384 + h * 64 + 8 * g;
        bf16x8 kf[8][2];
#pragma unroll
        for (int mt = 0; mt < 8; ++mt)
#pragma unroll
            for (int ks = 0; ks < 2; ++ks) kf[mt][ks] = *(const bf16x8*)(kp + mt * (16 * 384) + 32 * ks);
#pragma unroll
        for (int mt = 0; mt < 8; ++mt) { f32x4 s = {0.f, 0.f, 0.f, 0.f};
#pragma unroll
            for (int ks = 0; ks < 2; ++ks) s = __builtin_amdgcn_mfma_f32_16x16x32_bf16(kf[mt][ks], qf[ks], s, 0, 0, 0);
            f32x4 pf, pb;
#pragma unroll
            for (int rg = 0; rg < 4; ++rg) { const int d = i - (16 * mt + 4 * g + rg);
                pf[rg] = d >= 0 ? s[rg] * __builtin_amdgcn_exp2f(lgf * (float)d) : 0.f; pb[rg] = d <= 0 ? s[rg] * __builtin_amdgcn_exp2f(-lgb * (float)d) : 0.f; }
            u32x2 wf, wb; wf.x = cvtpk(pf.x, pf.y); wf.y = cvtpk(pf.z, pf.w); wb.x = cvtpk(pb.x, pb.y); wb.y = cvtpk(pb.z, pb.w);
            *(LAS u32x2*)(Pf + l16 * SV + (16 * mt + 4 * g) * 2) = wf; *(LAS u32x2*)(Pb + l16 * SV + (16 * mt + 4 * g) * 2) = wb; }
    }
    LDS_WAIT(); __builtin_amdgcn_sched_barrier(0);
    const unsigned vbase = (unsigned)(size_t)Vl;
#pragma unroll 1
    for (int ks = 0; ks < 4; ++ks) {
        const bool dof = (32 * ks <= q0 + 15), dob = (32 * ks + 31 >= q0);
        const bf16x8 af = *(const LAS bf16x8*)(Pf + l16 * SV + (32 * ks + 8 * g) * 2), ab = *(const LAS bf16x8*)(Pb + l16 * SV + (32 * ks + 8 * g) * 2);
        s16x4 vl[8], vh[8];
#pragma unroll
        for (int n = 0; n < 8; ++n) tr_frag_issue(vbase, SV, ks, 16 * n, F.lane, vl[n], vh[n]);
        asm volatile("s_waitcnt lgkmcnt(0)" ::: "memory"); __builtin_amdgcn_sched_barrier(0);
        if (dof) {
#pragma unroll
            for (int n = 0; n < 8; ++n) acc[0][n] = __builtin_amdgcn_mfma_f32_16x16x32_bf16(RET_PK(vl[n], vh[n]), af, acc[0][n], 0, 0, 0); }
        if (dob) {
#pragma unroll
            for (int n = 0; n < 8; ++n) acc[1][n] = __builtin_amdgcn_mfma_f32_16x16x32_bf16(RET_PK(vl[n], vh[n]), ab, acc[1][n], 0, 0, 0); }
    }
    {
        const int row = r0 + q0 + l16;
        float mean[2], rstd[2];
#pragma unroll
        for (int d = 0; d < 2; ++d) { float s_ = 0.f;
#pragma unroll
            for (int n = 0; n < 8; ++n) s_ += (acc[d][n].x + acc[d][n].y) + (acc[d][n].z + acc[d][n].w);
            s_ += xor16_f(s_); s_ = sum_xor32(s_);
            const float mu = s_ * (1.f / 128.f); float v_ = 0.f;
#pragma unroll
            for (int n = 0; n < 8; ++n) { const f32x4 x = acc[d][n] - mu; v_ += (x.x * x.x + x.y * x.y) + (x.z * x.z + x.w * x.w); }
            v_ += xor16_f(v_); v_ = sum_xor32(v_);
            mean[d] = mu; rstd[d] = __builtin_amdgcn_rsqf(v_ * (1.f / 128.f) + LN_EPS); }
        const bf16_t* gf = RGF + (size_t)row * 768 + h * 128 + 4 * g; const bf16_t* gb = RGB + (size_t)row * 768 + h * 128 + 4 * g;
        bf16_t* o = MIX + (size_t)row * D + 768 + h * 128 + 4 * g; unsigned char* o8 = (unsigned char*)(F.ws + WS_MIX8) + (size_t)row * D + 768 + h * 128 + 4 * g;
#pragma unroll
        for (int n = 0; n < 8; ++n) { const u32x2 a = *(const u32x2*)(gf + 16 * n), bb = *(const u32x2*)(gb + 16 * n);
            const f32x4 ga = {bflo(a.x), bfhi(a.x), bflo(a.y), bfhi(a.y)}, gbv = {bflo(bb.x), bfhi(bb.x), bflo(bb.y), bfhi(bb.y)};
            const f32x4 y = ga * ((acc[0][n] - mean[0]) * rstd[0]) + gbv * ((acc[1][n] - mean[1]) * rstd[1]);
            if (MK_OUT8) *(unsigned*)(o8 + 16 * n) = pk_fp8x4(y.x, y.y, y.z, y.w); else st8(o + 16 * n, y); }
    }
}
#undef RET_PK
}

constexpr float LOG2E = 1.4426950408889634f;
__device__ __forceinline__ void swa_units(const Frame& F, const Params& P, int l, int G2, int c2, int sigslot) {
    const bf16_t* SQ = (const bf16_t*)(F.ws + WS_SQ); const bf16_t* SK = (const bf16_t*)(F.ws + WS_SK); const bf16_t* SV = (const bf16_t*)(F.ws + WS_SV); bf16_t* MIX = (bf16_t*)(F.ws + WS_MIX);
    constexpr float scale = 0.08838834764831845f;
    const int NU = (l == DEPTH - 1) ? 384 : 408;
    bool sent = false;
    for (int u = G2 - 1 - c2; u < NU; u += G2) {
        int b, hq, row0, nB = 0, kB0 = 0, tq0 = 0, tkB0 = 0;
        if (u < 384) { b = u / 96; const int rem = u % 96; hq = rem >> 4; const int qb = rem & 15; row0 = b * TPB + NCTX + 256 * qb;
            const int lo = (256 * qb - 128 > 0) ? 256 * qb - 128 : 0, hi = (256 * qb + 384 < SEQ) ? 256 * qb + 384 : SEQ; nB = (hi - lo) >> 6; kB0 = NCTX + lo; tq0 = 256 * qb; tkB0 = lo; }
        else { const int v = u - 384; b = v / 6; hq = v % 6; row0 = b * TPB; }
        if (sigslot >= 0 && u + G2 >= NU) { conv_signal(F, sigslot); sent = true; }
        const float sink = P.in[I_SINK][l * 6 + hq];
        att::attn_unit<128, true>(SQ + (size_t)row0 * 768 + hq * 128, 768, SK + (size_t)b * TPB * 256 + (hq / 3) * 128, 256, SV + (size_t)b * TPB * 256 + (hq / 3) * 128, 256,
                                  MK_OUT8 ? (bf16_t*)((unsigned char*)(F.ws + WS_MIX8) + (size_t)row0 * D + hq * 128) : MIX + (size_t)row0 * D + hq * 128, D, 4, nB, kB0, tq0, tkB0, sink / scale, 1.f, scale * LOG2E, 8.f / scale, F.lds, F.wave);
    }
    if (sigslot >= 0 && !sent) conv_signal(F, sigslot);
}
__device__ __forceinline__ void mla_units(const Frame& F, const Params& P, int l) {
    const bf16_t* MQ = (const bf16_t*)(F.ws + WS_MQ); const bf16_t* KF = (const bf16_t*)(F.ws + WS_KF); const bf16_t* MV = (const bf16_t*)(F.ws + WS_MV); bf16_t* MIX = (bf16_t*)(F.ws + WS_MIX);
    constexpr float scale = 0.07216878364870323f;
    const int NU = (l == DEPTH - 1) ? 256 : 272;
    for (int u = F.G - 1 - F.bx; u < NU; u += F.G) {
        int b, h, row0, nA;
        if (u < 256) { b = u >> 6; h = (u >> 4) & 3; row0 = b * TPB + NCTX + 256 * (u & 15); nA = TPB / 64; }
        else { const int v = u - 256; b = v >> 2; h = v & 3; row0 = b * TPB; nA = NCTX / 64; }
        att::attn_unit<192, false>(MQ + (size_t)row0 * 768 + h * 192, 768, KF + (size_t)b * TPB * 768 + h * 192, 768, MV + (size_t)b * TPB * 512 + h * 128, 512,
                                   MK_OUT8 ? (bf16_t*)((unsigned char*)(F.ws + WS_MIX8) + (size_t)row0 * D + 1536 + h * 128) : MIX + (size_t)row0 * D + 1536 + h * 128, D, nA, 0, 0, 0, 0, -1e30f, 0.f, scale * LOG2E, 8.f / scale, F.lds, F.wave);
    }
}

constexpr int N_PHASES = 2 + 8 * DEPTH;
__global__ void __launch_bounds__(NTHREADS, 2) hybrid_dit_fwd(Params P) {
    extern __shared__ __attribute__((aligned(16))) unsigned char lds_raw[];
    Frame F0;
    F0.lds = (LAS unsigned char*)lds_raw; F0.ws = P.ws; F0.ctl = (unsigned*)(P.ws + WS_CTL);
    F0.tid = threadIdx.x; F0.lane = F0.tid & 63; F0.wave = __builtin_amdgcn_readfirstlane(F0.tid >> 6); F0.G = gridDim.x; F0.bx = blockIdx.x;
    __builtin_assume(F0.bx >= 0 && F0.bx < 256 && F0.G >= 1 && F0.G <= 256);
    volatile LAS unsigned* misc = (volatile LAS unsigned*)(F0.lds + MISC_OFF);
    if (F0.tid < 4) misc[F0.tid] = 0u;
    __syncthreads();
#if MK_PER_PHASE
#define GRID_BAR() do { } while (0)
#else
    XcdBarrier bar = xcd_barrier_post(F0.ctl + CW_BAR, misc);
#define GRID_BAR() xcd_barrier(bar, F0.wave)
#endif
#if MK_PER_PHASE
    const int lo = P.ph_lo, hi = P.ph_hi;
#else
    constexpr int lo = 0, hi = N_PHASES;
#endif
#define IN(k) (lo <= (k) && (k) < hi)
#define SEAM(k) do { if (IN(k) && IN((k) + 1)) GRID_BAR(); } while (0)
    if (IN(0) && PHEN(0)) { _Pragma("unroll 1") for (int rep_ = 0; rep_ < NREP(0); ++rep_) { if (rep_) GRID_BAR(); const Frame F = fresh_frame(F0); p0_prologue(F, P); } } SEAM(0);
    if (IN(1) && PHEN(1)) { _Pragma("unroll 1") for (int rep_ = 0; rep_ < NREP(1); ++rep_) { if (rep_) GRID_BAR(); const Frame F = fresh_frame(F0); phase_r1(F, P); } } SEAM(1);
#pragma unroll 1
    for (int l = 0; l < DEPTH; ++l) {
        const int pb = 2 + 8 * l;
        if (IN(pb + 0) && PHEN(2)) {
            const Frame F = fresh_frame(F0);
            const bool split = (F.G == 256) && (l == 0 || conv_remaining(F) > 0); const int ncomp = split ? F.G - NCONV : F.G;
            if (split && F.bx >= ncomp) converter_slot(F, P, l == 0 ? 0 : 4, 0, ncomp);
            else if (l == 0) {
                int off2 = 0;
                if (MK_F8SEL) {
                    constexpr int U1 = (NROWS / 256) * F8N1;
                    OpIn<true> o8; o8.A = (const unsigned char*)(F.ws + WS_H8); o8.Bt = (const unsigned char*)(F.ws + WS_WIN) + (size_t)INWP * D * 3; o8.G = ncomp; o8.c = F.bx; o8.npn = F8N1; o8.sel = 1;
                    o8.SQ = (bf16_t*)(F.ws + WS_SQ); o8.SK = (bf16_t*)(F.ws + WS_SK); o8.SV = (bf16_t*)(F.ws + WS_SV); o8.RQ = (bf16_t*)(F.ws + WS_RQ); o8.RK = (bf16_t*)(F.ws + WS_RK);
                    o8.RV = (bf16_t*)(F.ws + WS_RV); o8.RGF = (bf16_t*)(F.ws + WS_RGF); o8.RGB = (bf16_t*)(F.ws + WS_RGB); o8.MQ = (bf16_t*)(F.ws + WS_MQ); o8.CKV = (bf16_t*)(F.ws + WS_CKV);
                    o8.KF = (bf16_t*)(F.ws + WS_KF); o8.T32 = (const float*)(F.ws + WS_T32); o8.T16 = (const float*)(F.ws + WS_T16); o8.SS = (float*)(F.ws + WS_SSP);
                    o8.slab = F.lds + EPI_OFF + F.wave * EPI_SLAB; pg::gemm_phase<OpIn<true>>(F.lds, o8, F.wave);
                    off2 = ((U1 - F.bx + ncomp - 1) / ncomp) * ncomp - U1;
                }
                OpIn<false> op; op.off = off2; if (MK_F8SEL) { op.npn = INWP / 256 - F8N1; op.sel = 2; } op.A = (const unsigned char*)(F.ws + WS_H); op.Bt = (const unsigned char*)(F.ws + WS_WIN); op.G = ncomp; op.c = F.bx;
                op.SQ = (bf16_t*)(F.ws + WS_SQ); op.SK = (bf16_t*)(F.ws + WS_SK); op.SV = (bf16_t*)(F.ws + WS_SV); op.RQ = (bf16_t*)(F.ws + WS_RQ); op.RK = (bf16_t*)(F.ws + WS_RK);
                op.RV = (bf16_t*)(F.ws + WS_RV); op.RGF = (bf16_t*)(F.ws + WS_RGF); op.RGB = (bf16_t*)(F.ws + WS_RGB); op.MQ = (bf16_t*)(F.ws + WS_MQ); op.CKV = (bf16_t*)(F.ws + WS_CKV);
                op.KF = (bf16_t*)(F.ws + WS_KF); op.T32 = (const float*)(F.ws + WS_T32); op.T16 = (const float*)(F.ws + WS_T16); op.SS = (float*)(F.ws + WS_SSP);
                op.slab = F.lds + EPI_OFF + F.wave * EPI_SLAB; if (split) op.sig = F.ctl + CW_CONV + 64 * (1 + 0); pg::gemm_phase<OpIn<false>>(F.lds, op, F.wave);
            } else {
                OpIn<true> op; op.A = (const unsigned char*)(F.ws + WS_H8); op.Bt = (const unsigned char*)(F.ws + WS_WIN) + (size_t)INWP * D * 2; op.G = ncomp; op.c = F.bx;
                op.SQ = (bf16_t*)(F.ws + WS_SQ); op.SK = (bf16_t*)(F.ws + WS_SK); op.SV = (bf16_t*)(F.ws + WS_SV); op.RQ = (bf16_t*)(F.ws + WS_RQ); op.RK = (bf16_t*)(F.ws + WS_RK);
                op.RV = (bf16_t*)(F.ws + WS_RV); op.RGF = (bf16_t*)(F.ws + WS_RGF); op.RGB = (bf16_t*)(F.ws + WS_RGB); op.MQ = (bf16_t*)(F.ws + WS_MQ); op.CKV = (bf16_t*)(F.ws + WS_CKV);
                op.KF = (bf16_t*)(F.ws + WS_KF); op.T32 = (const float*)(F.ws + WS_T32); op.T16 = (const float*)(F.ws + WS_T16); op.SS = (float*)(F.ws + WS_SSP);
                op.slab = F.lds + EPI_OFF + F.wave * EPI_SLAB; if (split) op.sig = F.ctl + CW_CONV + 64 * (1 + 4); pg::gemm_phase<OpIn<true>>(F.lds, op, F.wave);
            }
        }
        SEAM(pb + 0);
        if (IN(pb + 1)) {
            const Frame F = fresh_frame(F0);
            const int NCH = (F.G >= 96) ? 48 : 0;
            if (NCH) { if (F.bx < NCH) ret::chain_unit(F, P, l, F.bx); }
            else { for (int u = F.bx; u < 48; u += F.G) ret::chain_unit(F, P, l, u); }
            const bool split = (F.G == 256) && (l == 0 || conv_remaining(F) > 0); const int ncv = split ? (l == 0 ? NCONV : 16) : 0;
            if (split && F.bx >= F.G - ncv) converter_slot(F, P, l == 0 ? 5 : 7, 0, F.G - NCH - ncv);
            else if (F.bx >= NCH) {
                const int G2 = F.G - NCH - ncv, c2 = F.bx - NCH;
                OpKv op; op.A = (const bf16_t*)(F.ws + WS_CKV); op.Bt = (const bf16_t*)(F.ws + WS_WUKV) + (size_t)l * 1024 * 256; op.G = G2; op.c = c2;
                op.KF = (bf16_t*)(F.ws + WS_KF); op.MV = (bf16_t*)(F.ws + WS_MV); op.SS = (const float*)(F.ws + WS_SSP);
                op.slab = F.lds + EPI_OFF + F.wave * EPI_SLAB; pg::gemm_phase<OpKv>(F.lds, op, F.wave);
                swa_units(F, P, l, G2, c2, split ? (l == 0 ? 5 : 7) : -1);
            }
        }
        SEAM(pb + 1);
        if (IN(pb + 2)) {
            if (PHEN(7)) { const Frame F = fresh_frame(F0); _Pragma("unroll 1") for (int rep_ = 0; rep_ < NREP(7); ++rep_) { if (rep_) GRID_BAR(); mla_units(F, P, l); } }
            if (PHEN(8)) { const Frame F = fresh_frame(F0);
                const bool split = (F.G == 256) && (l == 0 || conv_remaining(F) > 0); const int ncomp = split ? F.G - NCONV : F.G;
                if (split && F.bx >= ncomp) converter_slot(F, P, l == 0 ? 6 : 8, l == 0 ? 0 : MOE_ITEMS, ncomp);
                else { bool sent = false;
                       for (int u = F.bx; u < NBATCH * 6 * 34; u += ncomp) { if (split && !sent && u + ncomp >= NBATCH * 6 * 34) { conv_signal(F, l == 0 ? 6 : 8); sent = true; }
                           if (l == DEPTH - 1 && (u % 34) < 2) continue; ret::rc_unit(F, P, l, u); }
                       if (split && !sent) conv_signal(F, l == 0 ? 6 : 8);
                       if (split && l == DEPTH - 1) { __syncthreads(); converter_slot(F, P, 8, MOE_ITEMS, ncomp, true); } } }
        }
        SEAM(pb + 2);
        if (IN(pb + 3) && PHEN(9)) {
            const Frame F = fresh_frame(F0);
            const bool split = (l == 0) && (F.G == 256); const int ncomp = split ? F.G - NCONV_OUT : F.G;
            if (split && F.bx >= ncomp) converter_slot(F, P, 1, MOE_ITEMS_L, ncomp);
            else {
                OpOut op; op.A = (const unsigned char*)(F.ws + (MK_OUT8 ? WS_MIX8 : WS_MIX)); op.Bt = (const unsigned char*)(F.ws + WS_WOUT) + (size_t)l * D * D * (MK_OUT8 ? 1 : 2); op.G = ncomp; op.c = F.bx;
                op.Y = (bf16_t*)(F.ws + WS_Y); op.latent_only = (l == DEPTH - 1);
                op.slab = F.lds + EPI_OFF + F.wave * EPI_SLAB; if (split) op.sig = F.ctl + CW_CONV + 64 * (1 + 1); pg::gemm_phase<OpOut>(F.lds, op, F.wave);
                if (split) { __syncthreads(); converter_slot(F, P, 1, MOE_ITEMS_L, ncomp, true); }
            }
        }
        SEAM(pb + 3);
        if (IN(pb + 4) && PHEN(10)) { const Frame F = fresh_frame(F0); if (l == 0) conv_snapshot(F); phase_r4(F, P, l); }
        SEAM(pb + 4);
        if (IN(pb + 5) && PHEN(11)) {
            const Frame F = fresh_frame(F0);
            const bool split = (l == 0) && (F.G == 256) && (conv_remaining(F) > 0); const int ncomp = split ? F.G - NCONV : F.G;
            if (split && F.bx >= ncomp) converter_slot(F, P, 2, MOE_ITEMS_L, ncomp);
            else {
                OpMoe1 op; op.A = (const unsigned char*)(F.ws + WS_H8); op.Bt = (const unsigned char*)(F.ws + WS_WGU) + (size_t)l * NEXP * 2048 * D; op.G = ncomp; op.c = F.bx;
                op.tb = moe_tables(F, l); op.LISTE = (const int*)(F.ws + WS_LISTE); op.ACT = (unsigned char*)(F.ws + WS_ACT);
                if (split) op.sig = F.ctl + CW_CONV + 64 * (1 + 2); pg::gemm_phase<OpMoe1>(F.lds, op, F.wave);
            }
        }
        SEAM(pb + 5);
        if (IN(pb + 6) && PHEN(12)) {
            const Frame F = fresh_frame(F0);
            const bool split = (l == 0) && (F.G == 256) && (conv_remaining(F) > 0); const int ncomp = split ? F.G - NCONV : F.G;
            if (split && F.bx >= ncomp) converter_slot(F, P, 3, MOE_ITEMS_L, ncomp);
            else {
                OpMoe2 op; op.A = (const unsigned char*)(F.ws + WS_ACT); op.Bt = (const unsigned char*)(F.ws + WS_WDN) + (size_t)l * NEXP * D * EH; op.G = ncomp; op.c = F.bx;
                op.tb = moe_tables(F, l); op.LISTE = (const int*)(F.ws + WS_LISTE); op.AW = (const float*)(F.ws + WS_KVI); op.F2 = (unsigned char*)(F.ws + WS_F2);
                if (split) op.sig = F.ctl + CW_CONV + 64 * (1 + 3); pg::gemm_phase<OpMoe2>(F.lds, op, F.wave);
            }
        }
        SEAM(pb + 6);
        if (IN(pb + 7) && PHEN(13)) { const Frame F = fresh_frame(F0); if (l == 0) conv_snapshot(F); phase_r7(F, P, l); }
        SEAM(pb + 7);
    }
#undef IN
#undef SEAM
#undef GRID_BAR
}

extern "C" void kernel_launch(void* const* d_in, const int* in_sizes, int n_in, void* d_out, int out_size, void* d_ws, size_t ws_size, hipStream_t stream) {
    static int grid = 0;
    if (grid == 0) {
        if (n_in != 24 || out_size != NBATCH * SEQ * D || ws_size < WS_END) { fprintf(stderr, "kernel_launch: unexpected shapes: n_in %d out %d ws %zu (need %zu)\n", n_in, out_size, ws_size, (size_t)WS_END); grid = -1; return; }
        int dev = 0, cus = 0, per_cu = 0;
        if (hipGetDevice(&dev) != hipSuccess || hipDeviceGetAttribute(&cus, hipDeviceAttributeMultiprocessorCount, dev) != hipSuccess) { grid = -1; return; }
        if (hipFuncSetAttribute((const void*)hybrid_dit_fwd, hipFuncAttributeMaxDynamicSharedMemorySize, LDS_BYTES) != hipSuccess) { fprintf(stderr, "kernel_launch: hipFuncSetAttribute failed\n"); grid = -1; return; }
        if (hipOccupancyMaxActiveBlocksPerMultiprocessor(&per_cu, (const void*)hybrid_dit_fwd, NTHREADS, LDS_BYTES) != hipSuccess || per_cu < 1)
            fprintf(stderr, "kernel_launch: occupancy query reports %d blocks per CU\n", per_cu);
        (void)hipGetLastError();
        grid = cus < 256 ? cus : 256;
    }
    if (grid < 0) return;
    if (hipMemsetAsync((char*)d_ws + WS_CTL, 0, CTL_BYTES, stream) != hipSuccess) { fprintf(stderr, "kernel_launch: memset failed\n"); return; }
    Params p;
    memset(&p, 0, sizeof(p));
    for (int i = 0; i < 24; ++i) p.in[i] = (const float*)d_in[i];
    p.out = (float*)d_out; p.ws = (unsigned char*)d_ws;
#if MK_PER_PHASE
    for (int k = 0; k < N_PHASES; ++k) { p.ph_lo = k; p.ph_hi = k + 1; hipLaunchKernelGGL(hybrid_dit_fwd, dim3(grid), dim3(NTHREADS), LDS_BYTES, stream, p); }
#else
    p.ph_lo = 0; p.ph_hi = N_PHASES;
    hipLaunchKernelGGL(hybrid_dit_fwd, dim3(grid), dim3(NTHREADS), LDS_BYTES, stream, p);
#endif
    const hipError_t le = hipPeekAtLastError();
    if (le != hipSuccess) fprintf(stderr, "kernel_launch: launch failed: %s\n", hipGetErrorName(le));
}
```

```cpp
#include <hip/hip_runtime.h>
#include <stdint.h>
#include <stdio.h>
#include <string.h>

#ifndef MK_F8SEL
#define MK_F8SEL 2
#endif
#ifndef MK_OUT8
#define MK_OUT8 1
#endif
#ifndef MK_CONVPROBE
#define MK_CONVPROBE 0
#endif
#ifndef MK_PER_PHASE
#define MK_PER_PHASE 0
#endif

#ifndef MK_PHMASK
#define MK_PHMASK 0xFFFF
#endif
#define PHEN(k) (((MK_PHMASK) >> (k)) & 1)
#ifndef MK_DUP
#define MK_DUP 0
#endif
#define NREP(k) (1 + (((MK_DUP) >> (k)) & 1))
#define LAS __attribute__((address_space(3)))
typedef unsigned short bf16_t;
typedef short bf16x8 __attribute__((ext_vector_type(8)));
typedef short s16x4 __attribute__((ext_vector_type(4)));
typedef float f32x4 __attribute__((ext_vector_type(4)));
typedef float f32x16 __attribute__((ext_vector_type(16)));
typedef unsigned u32x4 __attribute__((ext_vector_type(4)));
typedef unsigned u32x2 __attribute__((ext_vector_type(2)));
typedef float f32x2 __attribute__((ext_vector_type(2)));

constexpr int D = 2048, NBATCH = 4, SEQ = 4096, NCTX = 256, TPB = SEQ + NCTX  ;
constexpr int NROWS = NBATCH * TPB;
constexpr int DEPTH = 2, INW = 5440, INWP = 5632, NEXP = 32, EH = 1024;
constexpr int NAID = 2 * NROWS;
constexpr int MAXSLOT = 43008;
constexpr float LN_EPS = 1e-6f;
constexpr float ALPHA = 1.4142135623730951f;
constexpr float F2SCALE = 16.f, F2SCALE_INV = 1.f / 16.f;
constexpr float WSCALE = 32.f, WSCALE_INV = 1.f / 32.f;

constexpr size_t MiB = 1u << 20;
constexpr size_t WS_CTL = 0, CTL_BYTES = 2 * MiB;
constexpr int CW_BAR = 0;
constexpr int CW_CNT = 4096;
constexpr int CW_SS = 8192;
constexpr int CW_CONV = 4608;
constexpr int CW_MOD = 65536;
static_assert((size_t)(CW_MOD + 2 * 5 * 12288) * 4 <= CTL_BYTES, "ctl region");
constexpr size_t WS_T32 = 2 * MiB;
constexpr size_t WS_T16 = WS_T32 + (size_t)4352 * 32 * 8;
constexpr size_t WS_SSP = 3 * MiB + 256 * 1024;
constexpr size_t WS_WR = 4 * MiB;
constexpr size_t WS_WUKV = 5 * MiB;
constexpr size_t WS_WOUT = 6 * MiB;
constexpr size_t WS_WIN = WS_WOUT + 16 * MiB;
constexpr size_t WS_WGU = WS_WIN + 44 * MiB;
constexpr size_t WS_WDN = WS_WGU + 256 * MiB;
constexpr size_t WS_H8 = WS_WDN + 128 * MiB;
constexpr size_t WS_X = WS_H8 + 34 * MiB;
constexpr size_t WS_H = WS_X + 136 * MiB;
constexpr size_t R768 = (size_t)NROWS * 768 * 2, R256 = (size_t)NROWS * 256 * 2, R384 = (size_t)NROWS * 384 * 2, R512 = (size_t)NROWS * 512 * 2, R2048 = (size_t)NROWS * 2048 * 2;
constexpr size_t WS_SQ = WS_H + 68 * MiB;
constexpr size_t WS_SK = WS_SQ + R768, WS_SV = WS_SK + R256, WS_RQ = WS_SV + R256, WS_RK = WS_RQ + R384, WS_RV = WS_RK + R384;
constexpr size_t WS_RGF = WS_RV + R768, WS_RGB = WS_RGF + R768, WS_MQ = WS_RGB + R768, WS_CKV = WS_MQ + R768, WS_KF = WS_CKV + R256, WS_MV = WS_KF + R768;
constexpr size_t WS_MIX = WS_MV + R512, WS_Y = WS_MIX + R2048;
constexpr size_t KVI_BYTES = (size_t)2 * 4 * 6 * 34 * 8192 * 4;
constexpr size_t WS_KVI = WS_Y + R2048, WS_SPREV = WS_KVI + KVI_BYTES;
constexpr size_t WS_MIX8 = WS_KVI + 8 * MiB;
constexpr size_t WS_LISTE = WS_SPREV + KVI_BYTES / 2;
constexpr size_t WS_AW = WS_LISTE + (size_t)NEXP * NAID * 4;
constexpr size_t WS_ACT = WS_AW + (size_t)NAID * 4;
constexpr size_t WS_F2 = WS_ACT + (size_t)MAXSLOT * EH;
constexpr size_t WS_END = WS_F2 + (size_t)NAID * 2048;

constexpr int RING_BYTES = 131072;
constexpr int MISC_OFF = RING_BYTES;
constexpr int EPI_OFF = RING_BYTES + 4096, EPI_SLAB = 16 * 144;
constexpr int LDS_BYTES = EPI_OFF + 8 * EPI_SLAB;
constexpr int NWAVES = 8, NTHREADS = 512;

__device__ __forceinline__ unsigned cvtpk(float lo, float hi) { unsigned r; asm volatile("v_cvt_pk_bf16_f32 %0, %1, %2" : "=v"(r) : "v"(lo), "v"(hi)); return r; }
__device__ __forceinline__ unsigned pk_fp8x4(float a, float b, float c, float d) { int r = 0; r = __builtin_amdgcn_cvt_pk_fp8_f32(a, b, r, false); r = __builtin_amdgcn_cvt_pk_fp8_f32(c, d, r, true); return (unsigned)r; }
__device__ __forceinline__ float bflo(unsigned w) { return __uint_as_float(w << 16); }
__device__ __forceinline__ float bfhi(unsigned w) { return __uint_as_float(w & 0xffff0000u); }
__device__ __forceinline__ int lane_id_fresh() { unsigned m = ~0u; asm volatile("" : "+s"(m)); return (int)__builtin_amdgcn_mbcnt_hi(m, __builtin_amdgcn_mbcnt_lo(m, 0u)); }
template <int CTRL> __device__ __forceinline__ float dpp_f(float v) { return __int_as_float(__builtin_amdgcn_update_dpp(0, __float_as_int(v), CTRL, 0xf, 0xf, true)); }
__device__ __forceinline__ float xor16_f(float v) { return __int_as_float(__builtin_amdgcn_ds_swizzle(__float_as_int(v), 0x401f)); }
__device__ __forceinline__ float sum_xor32(float v) { auto sw = __builtin_amdgcn_permlane32_swap(__float_as_uint(v), __float_as_uint(v), false, false); return __uint_as_float(sw[0]) + __uint_as_float(sw[1]); }
__device__ __forceinline__ float row16_sum(float v) {
    v += dpp_f<0xB1>(v); v += dpp_f<0x4E>(v); v += dpp_f<0x124>(v); v += dpp_f<0x128>(v); return v; }
__device__ __forceinline__ float wave_sum(float v) { v = row16_sum(v); v += xor16_f(v); return sum_xor32(v); }
__device__ __forceinline__ float siluf(float x) { return x * __builtin_amdgcn_rcpf(1.f + __expf(-x)); }
__device__ __forceinline__ void st8(bf16_t* p, const f32x4 v) { u32x2 w; w.x = cvtpk(v.x, v.y); w.y = cvtpk(v.z, v.w); *(u32x2*)p = w; }
#define LDS_WAIT() asm volatile("s_waitcnt lgkmcnt(0)" ::: "memory")
#define VM_WAIT() asm volatile("s_waitcnt vmcnt(0)" ::: "memory")

__device__ const float INVF32[32] = {
    1.000000000e+00f, 7.498942093e-01f, 5.623413252e-01f, 4.216965034e-01f, 3.162277660e-01f, 2.371373706e-01f, 1.778279410e-01f, 1.333521432e-01f,
    1.000000000e-01f, 7.498942093e-02f, 5.623413252e-02f, 4.216965034e-02f, 3.162277660e-02f, 2.371373706e-02f, 1.778279410e-02f, 1.333521432e-02f,
    1.000000000e-02f, 7.498942093e-03f, 5.623413252e-03f, 4.216965034e-03f, 3.162277660e-03f, 2.371373706e-03f, 1.778279410e-03f, 1.333521432e-03f,
    1.000000000e-03f, 7.498942093e-04f, 5.623413252e-04f, 4.216965034e-04f, 3.162277660e-04f, 2.371373706e-04f, 1.778279410e-04f, 1.333521432e-04f};

#define XB_TMO      128
#define XB_XCNT(j)  (256  + 64 * (j))
#define XB_XSUB(j)  (1280 + 64 * (j))
#define XB_XGEN(j)  (2304 + 64 * (j))
#define XB_TOP      3328
#define XB_TOPGEN   3392
#define XCD_BAR_WORDS 3456
#define XB_SPIN_CAP (1u << 18)
__device__ __forceinline__ unsigned xb_ld(unsigned* p)              { return __hip_atomic_load(p, __ATOMIC_RELAXED, __HIP_MEMORY_SCOPE_AGENT); }
__device__ __forceinline__ unsigned xb_add(unsigned* p, unsigned v) { return __hip_atomic_fetch_add(p, v, __ATOMIC_RELAXED, __HIP_MEMORY_SCOPE_AGENT); }
__device__ __forceinline__ unsigned xb_xcc_id() { return (unsigned)__builtin_amdgcn_s_getreg((3 << 11) | 20) & 0xFu; }
#define XB_SPIN(cond, bar) do { unsigned _sp = 0; while (cond) { __builtin_amdgcn_s_sleep(1); \
    if ((++_sp & 255u) == 0u) { if (xb_ld(&(bar)[XB_TMO])) break; if (_sp > XB_SPIN_CAP) { atomicAdd(&(bar)[XB_TMO], 1u); break; } } } } while (0)
struct XcdBarrier { unsigned* bar; unsigned x; volatile LAS unsigned* st; };
__device__ __forceinline__ XcdBarrier xcd_barrier_post(unsigned* bar, volatile LAS unsigned* st) {
    XcdBarrier b; b.bar = bar; b.x = xb_xcc_id(); b.st = st;
    if (threadIdx.x == 0) (void)xb_add(&bar[XB_XCNT(b.x)], 1u);
    return b;
}
__device__ __forceinline__ void xcd_barrier_complete(unsigned* bar, unsigned x, unsigned& nloc, unsigned& nx) {
    const unsigned G = gridDim.x * gridDim.y * gridDim.z;
    unsigned sum, cnt, mine, sp = 0u;
    for (;;) {
        sum = 0u; cnt = 0u; mine = 0u;
#pragma unroll
        for (unsigned j = 0; j < 16; ++j) { const unsigned c = xb_ld(&bar[XB_XCNT(j)]); sum += c; cnt += (c > 0u) ? 1u : 0u; mine = (j == x) ? c : mine; }
        if (sum == G) break;
        __builtin_amdgcn_s_sleep(1);
        if ((++sp & 255u) == 0u) { if (xb_ld(&bar[XB_TMO])) break; if (sp > XB_SPIN_CAP) { atomicAdd(&bar[XB_TMO], 1u); break; } }
    }
    nloc = mine > 0u ? mine : 1u; nx = cnt > 0u ? cnt : 1u;
}
__device__ __forceinline__ void xcd_barrier(const XcdBarrier& b0, int wave_) {
    XcdBarrier b; b.bar = b0.bar; b.st = b0.st; b.x = xb_xcc_id();
    asm volatile("s_waitcnt vmcnt(0)" ::: "memory");
    __syncthreads();
    const int t0_ = wave_ * 64 + lane_id_fresh();
    if (t0_ == 0) {
        unsigned* bar = b.bar;
        __builtin_amdgcn_s_waitcnt(0);
        unsigned nloc = b.st[0], nx = b.st[1];
        if (nloc == 0u) { xcd_barrier_complete(bar, b.x, nloc, nx); b.st[0] = nloc; b.st[1] = nx; }
        const unsigned old = xb_add(&bar[XB_XSUB(b.x)], 1u);
        const unsigned gen = old / nloc;
        if (old + 1u == (gen + 1u) * nloc) {
            __builtin_amdgcn_fence(__ATOMIC_RELEASE, "agent");
            asm volatile("s_waitcnt vmcnt(0)" ::: "memory");
            const unsigned og = xb_add(&bar[XB_TOP], 1u);
            const unsigned tg = og / nx;
            if (og + 1u == (tg + 1u) * nx) xb_add(&bar[XB_TOPGEN], 1u);
            else XB_SPIN(xb_ld(&bar[XB_TOPGEN]) == tg, bar);
            __builtin_amdgcn_fence(__ATOMIC_ACQUIRE, "agent");
            xb_add(&bar[XB_XGEN(b.x)], 1u);
            asm volatile("s_waitcnt vmcnt(0)" ::: "memory");
        } else {
            XB_SPIN(xb_ld(&bar[XB_XGEN(b.x)]) == gen, bar);
            __builtin_amdgcn_fence(__ATOMIC_ACQUIRE, "agent");
            asm volatile("s_waitcnt vmcnt(0)" ::: "memory");
        }
    }
    __syncthreads();
}

struct Params {
    const float* in[24];
    float* out;
    unsigned char* ws;
    int ph_lo, ph_hi;
};
enum { I_X = 0, I_C, I_CTX, I_CCTX, I_WADA, I_BADA, I_WIN, I_SINK, I_RDEC, I_KVN, I_WUK, I_WUV, I_WOUT, I_LN1G, I_LN1B, I_LN2G, I_LN2B,
       I_WGRP, I_BGRP, I_WEXP, I_BEXP, I_WGATE, I_WUP, I_WDOWN };

struct Frame {
    LAS unsigned char* lds;
    unsigned char* ws;
    unsigned* ctl;
    int tid, lane, wave, G, bx;
};
__device__ __forceinline__ Frame fresh_frame(const Frame& F0) {
    Frame F = F0; int w = F0.wave; asm volatile("" : "+s"(w)); F.wave = w; F.lane = lane_id_fresh(); F.tid = w * 64 + F.lane;
    size_t z = 0; asm volatile("" : "+s"(z)); F.ws = F0.ws + z; F.ctl = (unsigned*)(F.ws + WS_CTL);
    return F;
}

__device__ __forceinline__ void tr_item(const float* W, int N, int K, int k0, int n0, bf16_t* WT, int rb0, int rb1, const float* kscale, int lane) {
    const int kg = lane >> 3, n4 = lane & 7;
    const float* src = W + (size_t)(k0 + 8 * kg) * N + n0 + 4 * n4;
    f32x4 v[8];
#pragma unroll
    for (int j = 0; j < 8; ++j) v[j] = __builtin_nontemporal_load((const f32x4*)(src + (size_t)j * N));
    if (kscale) {
#pragma unroll
        for (int j = 0; j < 8; ++j) v[j] *= kscale[k0 + 8 * kg + j];
    }
#pragma unroll
    for (int i = 0; i < 4; ++i) { const int n = 4 * n4 + i; const int row = (n < 16) ? rb0 + n : rb1 + n - 16;
        u32x4 o; o.x = cvtpk(v[0][i], v[1][i]); o.y = cvtpk(v[2][i], v[3][i]); o.z = cvtpk(v[4][i], v[5][i]); o.w = cvtpk(v[6][i], v[7][i]);
        *(u32x4*)(WT + (size_t)row * K + k0 + 8 * kg) = o; }
}
template <bool TILED = false>
__device__ __forceinline__ void tr_item8(const float* W, int N, int K, int k0, int n0, unsigned char* WT, int rb0, int rb1, int lane) {
    const int kg = lane >> 3, n4 = lane & 7;
    const float* src = W + (size_t)(k0 + 16 * kg) * N + n0 + 4 * n4;
    f32x4 v[16];
#pragma unroll
    for (int j = 0; j < 16; ++j) v[j] = __builtin_nontemporal_load((const f32x4*)(src + (size_t)j * N)) * WSCALE;
#pragma unroll
    for (int i = 0; i < 4; ++i) { const int n = 4 * n4 + i; const int row = (n < 16) ? rb0 + n : rb1 + n - 16;
        u32x4 o; o.x = pk_fp8x4(v[0][i], v[1][i], v[2][i], v[3][i]); o.y = pk_fp8x4(v[4][i], v[5][i], v[6][i], v[7][i]);
        o.z = pk_fp8x4(v[8][i], v[9][i], v[10][i], v[11][i]); o.w = pk_fp8x4(v[12][i], v[13][i], v[14][i], v[15][i]);
        if (TILED) *(u32x4*)(WT + (size_t)(row >> 8) * 256 * K + (size_t)k0 * 256 + (row & 255) * 128 + 16 * kg) = o;
        else *(u32x4*)(WT + (size_t)row * K + k0 + 16 * kg) = o; }
}
struct Tr8Src { const float* src; int N; unsigned char* dst; int K, k0, rb0, rb1; };
__device__ __forceinline__ void tr8_load(const Tr8Src& t, int lane, f32x4 (&v)[16]) {
    const int kg = lane >> 3, n4 = lane & 7; const float* p = t.src + (size_t)(t.k0 + 16 * kg) * t.N + 4 * n4;
#pragma unroll
    for (int j = 0; j < 16; ++j) v[j] = __builtin_nontemporal_load((const f32x4*)(p + (size_t)j * t.N));
}
__device__ __forceinline__ void tr8_store(const Tr8Src& t, int lane, const f32x4 (&v)[16]) {
    const int kg = lane >> 3, n4 = lane & 7;
#pragma unroll
    for (int i = 0; i < 4; ++i) { const int n = 4 * n4 + i; const int row = (n < 16) ? t.rb0 + n : t.rb1 + n - 16;
        u32x4 o; o.x = pk_fp8x4(v[0][i] * WSCALE, v[1][i] * WSCALE, v[2][i] * WSCALE, v[3][i] * WSCALE); o.y = pk_fp8x4(v[4][i] * WSCALE, v[5][i] * WSCALE, v[6][i] * WSCALE, v[7][i] * WSCALE);
        o.z = pk_fp8x4(v[8][i] * WSCALE, v[9][i] * WSCALE, v[10][i] * WSCALE, v[11][i] * WSCALE); o.w = pk_fp8x4(v[12][i] * WSCALE, v[13][i] * WSCALE, v[14][i] * WSCALE, v[15][i] * WSCALE);
        __builtin_nontemporal_store(o, (u32x4*)(t.dst + (size_t)(row >> 8) * 256 * t.K + (size_t)t.k0 * 256 + (row & 255) * 128 + 16 * kg)); }
}
__device__ __forceinline__ int map16w(int n16) { const int tile = n16 >> 4, s16 = n16 & 15; return tile * 256 + (8 * ((s16 >> 1) & 1) + 2 * (s16 >> 2) + (s16 & 1)) * 16; }
#ifndef MK_F8MASK
#define MK_F8MASK 0x1FF10u
#endif
constexpr unsigned F8MASK = MK_F8SEL ? MK_F8MASK : 0u, BFMASK = 0x3FFFFFu & ~F8MASK;
constexpr int F8N1 = __builtin_popcount(F8MASK);
__device__ __forceinline__ int nth_bit(unsigned m, int i) { for (int k = 0; k < i; ++k) m &= m - 1u; return __builtin_ctz(m); }
constexpr int NB16 = 170 - 8 * F8N1, S_IN0 = 32 * NB16, S_IN1 = 16 * 170, S_IN8 = 16 * 8 * F8N1;
constexpr int S_IN = S_IN0 + S_IN1 + S_IN8, S_OUT = MK_OUT8 ? 2 * 16 * 64 : 2 * 32 * 64, S_UKV = 256, S_GU = 2 * 32 * 2 * 512, S_DN = 2 * 32 * 512;
constexpr int S_ALL = S_IN + S_OUT + S_UKV + S_GU + S_DN;

constexpr int MOE_ITEMS_L = 32768 + 16384, MOE_ITEMS = 2 * MOE_ITEMS_L;
__device__ __forceinline__ void moe_conv_item(const Params& P, unsigned char* ws, int idx, int lane) {
    const int l = (idx >= MOE_ITEMS_L) ? 1 : 0; int r = idx - l * MOE_ITEMS_L;
    if (r < 32768) { const int le = l * 32 + (r >> 10); r &= 1023; const int which = r >> 9; r &= 511; const int kb = r >> 5, nb = r & 31;
        if (which) tr_item8<true>(P.in[I_WUP] + (size_t)le * D * EH, EH, D, 128 * kb, 32 * nb, ws + WS_WGU + (size_t)le * 2048 * D, 64 * nb + 16, 64 * nb + 48, lane);
        else tr_item8<true>(P.in[I_WGATE] + (size_t)le * D * EH, EH, D, 128 * kb, 32 * nb, ws + WS_WGU + (size_t)le * 2048 * D, 64 * nb, 64 * nb + 32, lane); }
    else { r -= 32768; const int le = l * 32 + (r >> 9); r &= 511; const int kb = r >> 6, nb = r & 63;
        tr_item8<true>(P.in[I_WDOWN] + (size_t)le * EH * D, D, EH, 128 * kb, 32 * nb, ws + WS_WDN + (size_t)le * D * EH, 32 * nb, 32 * nb + 16, lane); }
}
__device__ __forceinline__ Tr8Src moe_item_desc(const Params& P, unsigned char* ws, int idx) {
    Tr8Src t; const int l = (idx >= MOE_ITEMS_L) ? 1 : 0; int r = idx - l * MOE_ITEMS_L;
    if (r < 32768) { const int le = l * 32 + (r >> 10); r &= 1023; const int which = r >> 9; r &= 511; const int kb = r >> 5, nb = r & 31;
        t.src = (which ? P.in[I_WUP] : P.in[I_WGATE]) + (size_t)le * D * EH + 32 * nb; t.N = EH; t.dst = ws + WS_WGU + (size_t)le * 2048 * D; t.K = D; t.k0 = 128 * kb; t.rb0 = 64 * nb + 16 * which; t.rb1 = t.rb0 + 32; }
    else { r -= 32768; const int le = l * 32 + (r >> 9); r &= 511; const int kb = r >> 6, nb = r & 63;
        t.src = P.in[I_WDOWN] + (size_t)le * EH * D + 32 * nb; t.N = D; t.dst = ws + WS_WDN + (size_t)le * D * EH; t.K = EH; t.k0 = 128 * kb; t.rb0 = 32 * nb; t.rb1 = t.rb0 + 16; }
    return t;
}
__device__ __forceinline__ int conv_claim16(const Frame& F) {
    int b = 0; if (F.lane == 0) b = (int)__hip_atomic_fetch_add(F.ctl + CW_CONV, 16u, __ATOMIC_RELAXED, __HIP_MEMORY_SCOPE_AGENT);
    return __builtin_amdgcn_readfirstlane(b);
}
__device__ __forceinline__ unsigned sload_fresh(const unsigned* p) { unsigned v; asm volatile("s_load_dword %0, %1, 0x0 glc\n\ts_waitcnt lgkmcnt(0)" : "=s"(v) : "s"(p) : "memory"); return v; }
__device__ __forceinline__ void converter_slot(const Frame& F, const Params& P, int slot, int must_end, int ncomp, bool join = false) {
    if (MK_CONVPROBE == 1) return;
    if (MK_CONVPROBE == 2) must_end = 0;
    const unsigned* done = F.ctl + CW_CONV + 64 * (1 + slot);
    volatile LAS int* cb = (volatile LAS int*)(F.lds + MISC_OFF + 32);
    f32x4 va[16], vb[16];
    if (F.wave == 0) { int b = MOE_ITEMS;
        const bool skip = join && (sload_fresh(done) >= (unsigned)ncomp) && ((int)sload_fresh(F.ctl + CW_CONV) >= must_end);
        if (!skip) b = conv_claim16(F); if (F.lane == 0) cb[0] = b; }
    asm volatile("s_waitcnt lgkmcnt(0)" ::: "memory"); __builtin_amdgcn_s_barrier();
    int base = __builtin_amdgcn_readfirstlane(cb[0]), par = 1;
    while (base < MOE_ITEMS) {
        const Tr8Src t0 = moe_item_desc(P, F.ws, base + 2 * F.wave), t1 = moe_item_desc(P, F.ws, base + 2 * F.wave + 1);
        tr8_load(t0, F.lane, va); tr8_load(t1, F.lane, vb);
        if (F.wave == 0) {
            const bool stop = (base + 16 >= must_end) && (sload_fresh(done) >= (unsigned)ncomp);
            int nb = MOE_ITEMS; if (!stop) nb = conv_claim16(F);
            if (F.lane == 0) cb[par] = nb;
        }
        tr8_store(t0, F.lane, va); tr8_store(t1, F.lane, vb);
        asm volatile("s_waitcnt lgkmcnt(0)" ::: "memory"); __builtin_amdgcn_s_barrier();
        base = __builtin_amdgcn_readfirstlane(cb[par]); par ^= 1;
    }
}
__device__ __forceinline__ void conv_snapshot(const Frame& F) { if (F.bx == 0 && F.wave == 0 && lane_id_fresh() == 0) { const unsigned c = __hip_atomic_load(F.ctl + CW_CONV, __ATOMIC_RELAXED, __HIP_MEMORY_SCOPE_AGENT); __hip_atomic_store(F.ctl + CW_CONV + 32, c, __ATOMIC_RELAXED, __HIP_MEMORY_SCOPE_AGENT); } }
__device__ __forceinline__ int conv_remaining(const Frame& F) { const int c = __builtin_amdgcn_readfirstlane((int)__hip_atomic_load(F.ctl + CW_CONV + 32, __ATOMIC_RELAXED, __HIP_MEMORY_SCOPE_AGENT)); return c >= MOE_ITEMS ? 0 : MOE_ITEMS - c; }
__device__ __forceinline__ void conv_signal(const Frame& F, int slot) { if (F.tid == 0) __hip_atomic_fetch_add(F.ctl + CW_CONV + 64 * (1 + slot), 1u, __ATOMIC_RELAXED, __HIP_MEMORY_SCOPE_AGENT); }
constexpr int NCONV = 42, NCONV_OUT = 74;

__device__ __forceinline__ void p0_prologue(const Frame& F, const Params& P) {
    unsigned char* ws = F.ws;
    {
        LAS float* sc = (LAS float*)F.lds;
        LAS float* red = sc + 5 * D;
        float* MOD = (float*)(F.ctl + CW_MOD);
        if (F.bx < 192) {
            for (int idx = F.tid; idx < 5 * D; idx += NTHREADS) { const int r = idx >> 11, k = idx & 2047; const float c = (r < 4) ? P.in[I_C][r * D + k] : P.in[I_CCTX][k]; sc[idx] = siluf(c); }
            __syncthreads();
        }
        for (int u = F.bx; u < 192; u += F.G) {
            const int l = u / 96, nblk = u % 96;
            const float* W = P.in[I_WADA] + ((size_t)l * D + 256 * F.wave) * 12288 + 128 * nblk + 2 * F.lane;
            f32x2 a0 = {0.f, 0.f}, a1 = a0, a2 = a0, a3 = a0, a4 = a0;
#pragma unroll 8
            for (int kk = 0; kk < 256; ++kk) { const f32x2 w = __builtin_nontemporal_load((const f32x2*)(W + (size_t)kk * 12288)); const int k = 256 * F.wave + kk;
                const float s0 = sc[k], s1 = sc[D + k], s2 = sc[2 * D + k], s3 = sc[3 * D + k], s4 = sc[4 * D + k];
                a0.x += s0 * w.x; a0.y += s0 * w.y; a1.x += s1 * w.x; a1.y += s1 * w.y; a2.x += s2 * w.x; a2.y += s2 * w.y; a3.x += s3 * w.x; a3.y += s3 * w.y; a4.x += s4 * w.x; a4.y += s4 * w.y; }
            LAS float* rw = red + F.wave * 640 + 2 * F.lane;
            *(LAS f32x2*)(rw) = a0; *(LAS f32x2*)(rw + 128) = a1; *(LAS f32x2*)(rw + 256) = a2; *(LAS f32x2*)(rw + 384) = a3; *(LAS f32x2*)(rw + 512) = a4;
            __syncthreads();
            for (int idx = F.tid; idx < 640; idx += NTHREADS) { const int r = idx >> 7, col = idx & 127; float s = 0.f;
#pragma unroll
                for (int w = 0; w < 8; ++w) s += red[w * 640 + idx];
                MOD[((size_t)l * 5 + r) * 12288 + 128 * nblk + col] = s + P.in[I_BADA][l * 12288 + 128 * nblk + col]; }
            __syncthreads();
        }
        __syncthreads();
    }
    {
        const int gt = F.bx * NTHREADS + F.tid, GT = F.G * NTHREADS;
        float2* T32 = (float2*)(ws + WS_T32); float2* T16 = (float2*)(ws + WS_T16);
        for (int idx = gt; idx < 4352 * 32 + 64 * 16; idx += GT) {
            int pos, f; float inv; float2* dst;
            if (idx < 4352 * 32) { pos = idx >> 5; f = idx & 31; inv = INVF32[f]; dst = T32 + idx; }
            else { const int j = idx - 4352 * 32; pos = j >> 4; f = j & 15; inv = INVF32[2 * f]; dst = T16 + j; }
            double rev = (double)pos * (double)inv * 0.15915494309189535; rev -= __builtin_rint(rev);
            const float fr = (float)rev; float2 cs; cs.x = __builtin_amdgcn_cosf(fr); cs.y = __builtin_amdgcn_sinf(fr); *dst = cs;
        }
        bf16_t* WR = (bf16_t*)(ws + WS_WR);
        for (int idx = gt; idx < 2 * 48 * 2048; idx += GT) { const int l = idx / (48 * 2048), r = idx % (48 * 2048), n = r >> 11, k = r & 2047; float v = 0.f;
            if (n < 4) v = P.in[I_WGRP][((size_t)l * D + k) * 4 + n]; else if (n < 36) v = P.in[I_WEXP][((size_t)l * D + k) * 32 + (n - 4)];
            WR[idx] = (bf16_t)(cvtpk(v, 0.f) & 0xffffu); }
        u32x4* WIN4 = (u32x4*)(ws + WS_WIN);
        for (int idx = gt; idx < 192 * 256 + 192 * 128; idx += GT) {
            if (idx < 192 * 256) { const int p = idx >> 8, row = 21 * 256 + (p < 96 ? 32 + p : 64 + p); WIN4[(size_t)row * 256 + (idx & 255)] = (u32x4){0u, 0u, 0u, 0u}; }
            else { const int i2 = idx - 192 * 256, p = i2 >> 7, row = 21 * 256 + (p < 96 ? 32 + p : 64 + p); WIN4[(size_t)INWP * 256 + (size_t)row * 128 + (i2 & 127)] = (u32x4){0u, 0u, 0u, 0u}; } }
    }
    {
        const int gw = F.bx * NWAVES + F.wave, NGW = F.G * NWAVES;
        const int nitems = S_IN + S_OUT + S_UKV + ((F.G == 256 && MK_CONVPROBE == 0) ? 0 : MOE_ITEMS);
        for (int it = gw; it < nitems; it += NGW) {
            int r = it; int kb, nb;
            if (r < S_IN) {
                if (r < S_IN0) { kb = r / NB16; nb = r % NB16; nb = 8 * nth_bit(BFMASK, nb >> 3) + (nb & 7);
                    tr_item(P.in[I_WIN], INW, D, 64 * kb, 32 * nb, (bf16_t*)(ws + WS_WIN), map16w(2 * nb), map16w(2 * nb + 1), nullptr, F.lane); }
                else if (r < S_IN0 + S_IN1) { r -= S_IN0; kb = r / 170; nb = r % 170;
                    tr_item8(P.in[I_WIN] + (size_t)D * INW, INW, D, 128 * kb, 32 * nb, ws + WS_WIN + (size_t)INWP * D * 2, map16w(2 * nb), map16w(2 * nb + 1), F.lane); }
                else { r -= S_IN0 + S_IN1; kb = r / (8 * F8N1 + (F8N1 == 0)); nb = r % (8 * F8N1 + (F8N1 == 0)); nb = 8 * nth_bit(F8MASK | (F8N1 == 0), nb >> 3) + (nb & 7);
                    tr_item8(P.in[I_WIN], INW, D, 128 * kb, 32 * nb, ws + WS_WIN + (size_t)INWP * D * 3, map16w(2 * nb), map16w(2 * nb + 1), F.lane); }
                continue; }
            else if (MK_OUT8 && (r - S_IN) < S_OUT) { r -= S_IN; const int l = r / 1024; r %= 1024; kb = r >> 6; nb = r & 63;
                tr_item8(P.in[I_WOUT] + (size_t)l * D * D, D, D, 128 * kb, 32 * nb, ws + WS_WOUT + (size_t)l * D * D, map16w(2 * nb), map16w(2 * nb + 1), F.lane); continue; }
            else if ((r -= S_IN) < S_OUT) { const int l = r / 2048; r %= 2048; kb = r >> 6; nb = r & 63;
                tr_item(P.in[I_WOUT] + (size_t)l * D * D, D, D, 64 * kb, 32 * nb, (bf16_t*)(ws + WS_WOUT) + (size_t)l * D * D, map16w(2 * nb), map16w(2 * nb + 1), nullptr, F.lane); continue; }
            else if ((r -= S_OUT) < S_UKV) { const int l = r >> 7; r &= 127; const int which = r >> 6; r &= 63; kb = r >> 4; nb = r & 15;
                bf16_t* dst = (bf16_t*)(ws + WS_WUKV) + (size_t)l * 1024 * 256; const float* ksc = P.in[I_KVN] + l * 256;
                if (which) tr_item(P.in[I_WUV] + (size_t)l * 256 * 512, 512, 256, 64 * kb, 32 * nb, dst, 512 + map16w(2 * nb), 512 + map16w(2 * nb + 1), ksc, F.lane);
                else tr_item(P.in[I_WUK] + (size_t)l * 256 * 512, 512, 256, 64 * kb, 32 * nb, dst, map16w(2 * nb), map16w(2 * nb + 1), ksc, F.lane);
                continue; }
            else { r -= S_UKV; moe_conv_item(P, ws, r, F.lane); continue; }
        }
    }
}

__device__ __forceinline__ void ln_stats(const f32x4 (&v)[8], float& mean, float& rstd) {
    float s = 0.f;
#pragma unroll
    for (int j = 0; j < 8; ++j) s += (v[j].x + v[j].y) + (v[j].z + v[j].w);
    mean = wave_sum(s) * (1.f / D);
    float s2 = 0.f;
#pragma unroll
    for (int j = 0; j < 8; ++j) { const f32x4 d = v[j] - mean; s2 += (d.x * d.x + d.y * d.y) + (d.z * d.z + d.w * d.w); }
    rstd = __builtin_amdgcn_rsqf(wave_sum(s2) * (1.f / D) + LN_EPS);
}
template <bool WITH16, bool WITH8>
__device__ __forceinline__ void modulate_store(const f32x4 (&v)[8], const float* shift, const float* scale, bf16_t* hrow, unsigned char* h8row, int lane) {
    float mean, rstd; ln_stats(v, mean, rstd);
#pragma unroll
    for (int j = 0; j < 8; ++j) { const f32x4 sh = ((const f32x4*)shift)[lane + 64 * j], sc = ((const f32x4*)scale)[lane + 64 * j];
        const f32x4 o = (v[j] - mean) * rstd * (sc + 1.f) + sh;
        if (WITH16) { u32x2 w; w.x = cvtpk(o.x, o.y); w.y = cvtpk(o.z, o.w); ((u32x2*)hrow)[lane + 64 * j] = w; }
        if (WITH8) ((unsigned*)h8row)[lane + 64 * j] = pk_fp8x4(o.x, o.y, o.z, o.w); }
}
__device__ __forceinline__ void affine_ln(f32x4 (&v)[8], const float* g, const float* b, int lane) {
    float mean, rstd; ln_stats(v, mean, rstd);
#pragma unroll
    for (int j = 0; j < 8; ++j) { const f32x4 gg = ((const f32x4*)g)[lane + 64 * j], bb = ((const f32x4*)b)[lane + 64 * j]; v[j] = (v[j] - mean) * rstd * gg + bb; }
}
__device__ __forceinline__ const float* src_row0(const Params& P, int r) {
    const int b = r / TPB, j = r - b * TPB;
    return j < NCTX ? P.in[I_CTX] + ((size_t)b * NCTX + j) * D : P.in[I_X] + ((size_t)b * SEQ + (j - NCTX)) * D;
}
__device__ __forceinline__ int mod_row(int r) { const int b = r / TPB, j = r - b * TPB; return j < NCTX ? 4 : b; }
__device__ __forceinline__ int latent_row(int q) { return (q >> 12) * TPB + NCTX + (q & 4095); }

__device__ __forceinline__ void row_load_bf16(const bf16_t* p, int lane, f32x4 (&v)[8]) {
#pragma unroll
    for (int j = 0; j < 8; ++j) { const u32x2 a = ((const u32x2*)p)[lane + 64 * j]; v[j] = (f32x4){bflo(a.x), bfhi(a.x), bflo(a.y), bfhi(a.y)}; }
}
__device__ __forceinline__ void row_store_bf16(bf16_t* p, int lane, const f32x4 (&v)[8]) {
#pragma unroll
    for (int j = 0; j < 8; ++j) { u32x2 w; w.x = cvtpk(v[j].x, v[j].y); w.y = cvtpk(v[j].z, v[j].w); ((u32x2*)p)[lane + 64 * j] = w; }
}
__device__ __forceinline__ void phase_r1(const Frame& F, const Params& P) {
    const float* MOD = (const float*)(F.ctl + CW_MOD); bf16_t* H = (bf16_t*)(F.ws + WS_H);
    const int gw = F.bx * NWAVES + F.wave, NGW = F.G * NWAVES;
    for (int r = gw; r < NROWS; r += NGW) {
        const float* xr = src_row0(P, r); f32x4 v[8];
#pragma unroll
        for (int j = 0; j < 8; ++j) v[j] = ((const f32x4*)xr)[F.lane + 64 * j];
        const float* m = MOD + (size_t)mod_row(r) * 12288;
        modulate_store<true, (MK_F8SEL != 0)>(v, m, m + D, H + (size_t)r * D, (unsigned char*)(F.ws + WS_H8) + (size_t)r * D, F.lane);
    }
}
__device__ __forceinline__ void phase_r7(const Frame& F, const Params& P, int l) {
    const float* MOD = (const float*)(F.ctl + CW_MOD); bf16_t* H = (bf16_t*)(F.ws + WS_H); bf16_t* X = (bf16_t*)(F.ws + WS_X); const unsigned char* F2 = (const unsigned char*)(F.ws + WS_F2);
    const bool last = (l == DEPTH - 1); const int NR = last ? NBATCH * SEQ : NROWS;
    const int gw = F.bx * NWAVES + F.wave, NGW = F.G * NWAVES;
    for (int q = gw; q < NR; q += NGW) {
        const int r = last ? latent_row(q) : q; const int mr = mod_row(r);
        bf16_t* xr = X + (size_t)r * D; f32x4 v[8], xv[8]; row_load_bf16(xr, F.lane, xv);
        const float* gate = MOD + ((size_t)l * 5 + mr) * 12288 + 5 * D;
        const unsigned* f0 = (const unsigned*)(F2 + (size_t)(2 * r) * D); const unsigned* f1 = (const unsigned*)(F2 + (size_t)(2 * r + 1) * D);
#pragma unroll
        for (int j = 0; j < 8; ++j) { const f32x4 x = xv[j], g = ((const f32x4*)gate)[F.lane + 64 * j]; const unsigned a = f0[F.lane + 64 * j], b = f1[F.lane + 64 * j];
            const auto a0 = __builtin_amdgcn_cvt_pk_f32_fp8((int)a, false), a1 = __builtin_amdgcn_cvt_pk_f32_fp8((int)a, true), b0 = __builtin_amdgcn_cvt_pk_f32_fp8((int)b, false), b1 = __builtin_amdgcn_cvt_pk_f32_fp8((int)b, true);
            f32x4 f; f.x = (a0[0] + b0[0]) * F2SCALE_INV; f.y = (a0[1] + b0[1]) * F2SCALE_INV; f.z = (a1[0] + b1[0]) * F2SCALE_INV; f.w = (a1[1] + b1[1]) * F2SCALE_INV;
            v[j] = x * ALPHA + g * f; }
        affine_ln(v, P.in[I_LN2G] + l * D, P.in[I_LN2B] + l * D, F.lane);
        if (last) { float* o = P.out + (size_t)q * D;
#pragma unroll
            for (int j = 0; j < 8; ++j) ((f32x4*)o)[F.lane + 64 * j] = v[j];
        } else {
            row_store_bf16(xr, F.lane, v);
            const float* m = MOD + ((size_t)(l + 1) * 5 + mr) * 12288;
            modulate_store<false, true>(v, m, m + D, nullptr, (unsigned char*)(F.ws + WS_H8) + (size_t)r * D, F.lane);
        }
    }
}

__device__ __forceinline__ void phase_r4(const Frame& F, const Params& P, int l) {
    const float* MOD = (const float*)(F.ctl + CW_MOD); bf16_t* H = (bf16_t*)(F.ws + WS_H); bf16_t* X = (bf16_t*)(F.ws + WS_X); const bf16_t* Y = (const bf16_t*)(F.ws + WS_Y);
    const bf16_t* WR = (const bf16_t*)(F.ws + WS_WR) + (size_t)l * 48 * D;
    int* LISTE = (int*)(F.ws + WS_LISTE); float* AW = (float*)(F.ws + WS_KVI); unsigned* CNT = F.ctl + CW_CNT + 64 * l;
    const bool last = (l == DEPTH - 1); const int NR = last ? NBATCH * SEQ : NROWS;
    int g_ = F.G; asm volatile("" : "+s"(g_));
    const int RPB = (NR + g_ - 1) / g_, rbeg = F.bx * RPB, rend = (rbeg + RPB < NR) ? rbeg + RPB : NR;
    LAS float* logits = (LAS float*)F.lds;
    LAS int* cntl = (LAS int*)(F.lds + MISC_OFF + 1024);
    LAS int* basel = cntl + 32;
    const int g16 = F.lane >> 4, l16 = F.lane & 15;
    for (int c0 = rbeg; c0 < rend; c0 += 80) {
        const int nrow = (rend - c0 < 80) ? rend - c0 : 80;
        if (F.tid < 32) cntl[F.tid] = 0;
        for (int i = F.wave; i < nrow; i += NWAVES) {
            const int q = c0 + i, r = last ? latent_row(q) : q, mr = mod_row(r);
            const float* m = MOD + ((size_t)l * 5 + mr) * 12288;
            const u32x2* yr = (const u32x2*)(Y + (size_t)r * D); f32x4 v[8], xv[8];
            if (l == 0) { const float* xr = src_row0(P, r);
#pragma unroll
                for (int j = 0; j < 8; ++j) xv[j] = ((const f32x4*)xr)[F.lane + 64 * j]; }
            else row_load_bf16(X + (size_t)r * D, F.lane, xv);
#pragma unroll
            for (int j = 0; j < 8; ++j) { const f32x4 x = xv[j], g = ((const f32x4*)(m + 2 * D))[F.lane + 64 * j]; const u32x2 a = yr[F.lane + 64 * j];
                f32x4 y; y.x = bflo(a.x); y.y = bfhi(a.x); y.z = bflo(a.y); y.w = bfhi(a.y); v[j] = x * ALPHA + g * y; }
            affine_ln(v, P.in[I_LN1G] + l * D, P.in[I_LN1B] + l * D, F.lane);
            row_store_bf16(X + (size_t)r * D, F.lane, v);
            modulate_store<true, true>(v, m + 3 * D, m + 4 * D, H + (size_t)r * D, (unsigned char*)(F.ws + WS_H8) + (size_t)r * D, F.lane);
        }
        VM_WAIT(); __syncthreads();
        {
            f32x4 acc[5][3];
#pragma unroll
            for (int a = 0; a < 5; ++a)
#pragma unroll
                for (int b = 0; b < 3; ++b) acc[a][b] = (f32x4){0.f, 0.f, 0.f, 0.f};
            const bf16_t* arow[5];
#pragma unroll
            for (int mt = 0; mt < 5; ++mt) { int i = 16 * mt + l16; i = i < nrow ? i : nrow - 1; const int q = c0 + i, r = last ? latent_row(q) : q; arow[mt] = H + (size_t)r * D + 256 * F.wave + 8 * g16; }
            const bf16_t* brow = WR + (size_t)l16 * D + 256 * F.wave + 8 * g16;
#pragma unroll 2
            for (int ks = 0; ks < 8; ++ks) {
                bf16x8 bf[3];
#pragma unroll
                for (int nt = 0; nt < 3; ++nt) bf[nt] = *(const bf16x8*)(brow + (size_t)nt * 16 * D + 32 * ks);
#pragma unroll
                for (int mt = 0; mt < 5; ++mt) { const bf16x8 af = *(const bf16x8*)(arow[mt] + 32 * ks);
#pragma unroll
                    for (int nt = 0; nt < 3; ++nt) acc[mt][nt] = __builtin_amdgcn_mfma_f32_16x16x32_bf16(af, bf[nt], acc[mt][nt], 0, 0, 0); }
            }
#pragma unroll
            for (int mt = 0; mt < 5; ++mt)
#pragma unroll
                for (int nt = 0; nt < 3; ++nt)
#pragma unroll
                    for (int rg = 0; rg < 4; ++rg) logits[F.wave * 3840 + (16 * mt + 4 * g16 + rg) * 48 + 16 * nt + l16] = acc[mt][nt][rg];
        }
        __syncthreads();
        int E1 = 0, E2 = 0, p1 = 0, p2 = 0, r = 0; float w1 = 0.f, w2 = 0.f;
        if (F.tid < nrow) {
            const int q = c0 + F.tid; r = last ? latent_row(q) : q;
            const LAS float* lg = logits + F.tid * 48;
            const float* bg = P.in[I_BGRP] + l * 4; const float* be = P.in[I_BEXP] + l * 32;
            float gl[4];
#pragma unroll
            for (int n = 0; n < 4; ++n) { float a = 0.f;
#pragma unroll
                for (int w = 0; w < 8; ++w) a += lg[w * 3840 + n];
                gl[n] = a + bg[n]; }
            int g = 0; float gm = gl[0];
#pragma unroll
            for (int n = 1; n < 4; ++n) if (gl[n] > gm) { gm = gl[n]; g = n; }
            float gs = 0.f;
#pragma unroll
            for (int n = 0; n < 4; ++n) gs += __expf(gl[n] - gm);
            const float pg = 1.f / gs;
            float e1 = -3.0e38f, e2 = -3.0e38f; int i1 = 0, i2 = 0;
            for (int k = 0; k < 8; ++k) { float e = 0.f;
#pragma unroll
                for (int w = 0; w < 8; ++w) e += lg[w * 3840 + 4 + 8 * g + k];
                e += be[8 * g + k];
                if (e > e1) { e2 = e1; i2 = i1; e1 = e; i1 = k; } else if (e > e2) { e2 = e; i2 = k; } }
            const float s1 = 1.f / (1.f + __expf(e2 - e1));
            w1 = s1 * pg; w2 = (1.f - s1) * pg; E1 = 8 * g + i1; E2 = 8 * g + i2;
            p1 = __hip_atomic_fetch_add(&cntl[E1], 1, __ATOMIC_RELAXED, __HIP_MEMORY_SCOPE_WORKGROUP);
            p2 = __hip_atomic_fetch_add(&cntl[E2], 1, __ATOMIC_RELAXED, __HIP_MEMORY_SCOPE_WORKGROUP);
        }
        __syncthreads();
        if (F.tid < 32) { const int c = cntl[F.tid]; basel[F.tid] = c ? (int)__hip_atomic_fetch_add(&CNT[F.tid], (unsigned)c, __ATOMIC_RELAXED, __HIP_MEMORY_SCOPE_AGENT) : 0; }
        __syncthreads();
        if (F.tid < nrow) {
            LISTE[(size_t)E1 * NAID + basel[E1] + p1] = 2 * r; AW[(size_t)E1 * NAID + basel[E1] + p1] = w1;
            LISTE[(size_t)E2 * NAID + basel[E2] + p2] = 2 * r + 1; AW[(size_t)E2 * NAID + basel[E2] + p2] = w2;
        }
        __syncthreads();
    }
}

namespace pg {
constexpr int BM = 256, BK = 64, HALF = 128, HTB = HALF * BK * 2, NXCD = 8, WGM = 8;
__device__ __forceinline__ int lds_byte(int r, int c) { const int st = (r >> 4) * 2 + (c >> 5), rr = r & 15, cc = c & 31, ob = rr * 64 + cc * 2; return st * 1024 + (ob ^ (((ob >> 9) & 1) << 5)); }
__device__ __forceinline__ void stage_rc(int b, int& R, int& C) { const int st = b / 1024, sb = b % 1024, swz = sb ^ (((sb >> 9) & 1) << 5); R = (st >> 1) * 16 + swz / 64; C = (st & 1) * 32 + (swz % 64) / 2; }
__device__ __forceinline__ bool tile_order(long L, int nM, int nN, int& pm, int& pn) {
    const int nwg = nM * nN; if (L >= nwg) return false;
    int wgid = (int)L; { const int q = nwg / NXCD, r = nwg % NXCD, xcd = wgid % NXCD, off = wgid / NXCD; wgid = (xcd < r ? xcd * (q + 1) : r * (q + 1) + (xcd - r) * q) + off; }
    const int nig = WGM * nN, gid = wgid / nig, fm = gid * WGM, gsz = (nM - fm) < WGM ? (nM - fm) : WGM;
    pm = fm + ((wgid % nig) % gsz); pn = (wgid % nig) / gsz; return true;
}
struct Unit { int pm, pn, e, aux; };
typedef int i32x8 __attribute__((ext_vector_type(8)));
__device__ __forceinline__ i32x8 cat8(bf16x8 a, bf16x8 b) { union { struct { bf16x8 x, y; } p; i32x8 v; } u; u.p.x = a; u.p.y = b; return u.v; }

template <class Op>
__device__ __forceinline__ void gemm_phase(LAS unsigned char* lds, const Op& op, int wave_) {
    constexpr int ROWB = Op::ROWB, nt = ROWB / (BK * 2);
    const int lane = lane_id_fresh(), wid = wave_, tid = wid * 64 + lane, wr = wid >> 2, wc = wid & 3, fr = lane & 15, fq = lane >> 4;
    unsigned voffB[2];
#pragma unroll
    for (int i = 0; i < 2; ++i) { int R_, C_; stage_rc(tid * 16 + i * 8192, R_, C_); voffB[i] = (unsigned)(R_ * Op::BROWB + C_ * 2); }
#define PG_AOFF(unit, o0, o1) do { const int t2_ = wid * 64 + lane_id_fresh(); int Rn_[2], Cn_[2]; stage_rc(t2_ * 16, Rn_[0], Cn_[0]); stage_rc(t2_ * 16 + 8192, Rn_[1], Cn_[1]); op.a_off(unit, Rn_, Cn_, o0, o1); } while (0)
    constexpr size_t kstep = (size_t)BK * 2, hstepB = (size_t)HALF * Op::BROWB, bstep = (size_t)Op::BKSTEP;
    const unsigned ldsw = (unsigned)wid * 1024u;
    const int aoff = lds_byte(wr * 64 + fr, fq * 8), boff = lds_byte(wc * 32 + fr, fq * 8);
#define PG_SA(b, h) (((b) * 2 + (h)) * HTB)
#define PG_SB(b, h) ((4 + (b) * 2 + (h)) * HTB)
#define PG_STAGE_A(bufoff, offs, kb) do { _Pragma("unroll") for (int _i = 0; _i < 2; ++_i) \
        __builtin_amdgcn_global_load_lds((const unsigned*)(gA + (kb) + (offs)[_i]), (LAS unsigned*)(lds + (bufoff) + ldsw + _i * 8192), 16, 0, 0); } while (0)
#define PG_STAGE_B(bufoff, gbase, kb) do { _Pragma("unroll") for (int _i = 0; _i < 2; ++_i) \
        __builtin_amdgcn_global_load_lds((const unsigned*)((gbase) + (kb) + voffB[_i]), (LAS unsigned*)(lds + (bufoff) + ldsw + _i * 8192), 16, 0, 0); } while (0)
#define PG_LD8(off) cat8(*(const LAS bf16x8*)(lds + (off)), *(const LAS bf16x8*)(lds + (off) + 1024))
#define PG_LDA(dst, b, h) do { if constexpr (Op::FP8) { _Pragma("unroll") for (int m = 0; m < 4; ++m) dst##8[m] = PG_LD8(PG_SA(b, h) + aoff + m * 2048); } \
        else { _Pragma("unroll") for (int m = 0; m < 4; ++m) _Pragma("unroll") for (int k = 0; k < 2; ++k) dst[m][k] = *(const LAS bf16x8*)(lds + PG_SA(b, h) + aoff + m * 2048 + k * 1024); } } while (0)
#define PG_LDB(dst, b, h) do { if constexpr (Op::FP8) { _Pragma("unroll") for (int n = 0; n < 2; ++n) dst##8[n] = PG_LD8(PG_SB(b, h) + boff + n * 2048); } \
        else { _Pragma("unroll") for (int n = 0; n < 2; ++n) _Pragma("unroll") for (int k = 0; k < 2; ++k) dst[n][k] = *(const LAS bf16x8*)(lds + PG_SB(b, h) + boff + n * 2048 + k * 1024); } } while (0)
#define PG_MMA(ai, bj, At, Bt) do { __builtin_amdgcn_s_setprio(1); _Pragma("unroll") for (int m = 0; m < 4; ++m) _Pragma("unroll") for (int n = 0; n < 2; ++n) { \
        if constexpr (Op::FP8) { asm volatile("v_mfma_scale_f32_16x16x128_f8f6f4 %0, %1, %2, %0, %3, %3 op_sel_hi:[0,0,0]" : "+v"(acc[ai][bj][m][n]) : "v"(Bt##8[n]), "v"(At##8[m]), "v"(sc1)); } \
        else { _Pragma("unroll") for (int k = 0; k < 2; ++k) acc[ai][bj][m][n] = __builtin_amdgcn_mfma_f32_16x16x32_bf16(Bt[n][k], At[m][k], acc[ai][bj][m][n], 0, 0, 0); } } \
        __builtin_amdgcn_s_setprio(0); } while (0)
#define PG_WAIT_V(n) asm volatile("s_waitcnt vmcnt(" #n ")" ::: "memory")
#define PG_WAIT_L(n) asm volatile("s_waitcnt lgkmcnt(" #n ")" ::: "memory")
#define PG_BAR __builtin_amdgcn_s_barrier()
#define PG_SCHED __builtin_amdgcn_sched_barrier(0)
    Unit cur, nxt; int ui = 0;
    if (!op.next(0, cur)) { op.pre_done(wid); return; }
    constexpr int TSIG = (nt > 8) ? nt - 8 : 0;
    f32x4 acc[2][2][4][2];
#pragma unroll
    for (int a = 0; a < 2; ++a)
#pragma unroll
        for (int b = 0; b < 2; ++b)
#pragma unroll
            for (int m = 0; m < 4; ++m)
#pragma unroll
                for (int n = 0; n < 2; ++n) acc[a][b][m][n] = (f32x4){0.f, 0.f, 0.f, 0.f};
    bf16x8 At[4][2], B0[2][2], B1[2][2]; i32x8 At8[4], B08[2], B18[2];
    int sc1 = 0x7f7f7f7f; asm volatile("" : "+v"(sc1));
    const char* const gA = (const char*)op.a_base();
    unsigned ca0[2], ca1[2], na0[2], na1[2];
    PG_AOFF(cur, ca0, ca1);
    const char* cB = (const char*)op.b_base(cur);
    PG_STAGE_B(PG_SB(0, 0), cB, 0); PG_STAGE_B(PG_SB(0, 1), cB + hstepB, 0); PG_STAGE_A(PG_SA(0, 0), ca0, 0); PG_STAGE_A(PG_SA(0, 1), ca1, 0);
    if (wr == 1) PG_BAR;
    PG_WAIT_V(2); PG_BAR;
    PG_STAGE_B(PG_SB(1, 0), cB, bstep); PG_STAGE_A(PG_SA(1, 0), ca0, kstep); PG_STAGE_B(PG_SB(1, 1), cB + hstepB, bstep);
    PG_WAIT_V(6); PG_BAR;
    for (;;) {
        const bool has_next = op.next(ui + 1, nxt);
        const char* nB = cB;
        if (has_next) { PG_AOFF(nxt, na0, na1); nB = (const char*)op.b_base(nxt); }
        else { na0[0] = ca0[0]; na0[1] = ca0[1]; na1[0] = ca1[0]; na1[1] = ca1[1]; }
#pragma unroll 1
        for (int t = 0; t < nt; t += 2) {
            const bool last = (t == nt - 2);
            if (t == TSIG && !has_next) op.pre_done(wid);
            const size_t k1 = (size_t)(t + 1) * kstep, k2 = last ? 0 : (size_t)(t + 2) * kstep, k3 = k2 + kstep, k2b = last ? 0 : (size_t)(t + 2) * bstep, k3b = k2b + bstep;
            const char* b2 = last ? nB : cB;
            PG_LDB(B0, 0, 0); PG_LDB(B1, 0, 1); PG_SCHED; PG_LDA(At, 0, 0); PG_STAGE_A(PG_SA(1, 1), ca1, k1);
            PG_WAIT_V(8); PG_WAIT_L(0); PG_BAR; PG_MMA(0, 0, At, B0); PG_MMA(0, 1, At, B1); PG_BAR; PG_SCHED;
            if (last) { ca0[0] = na0[0]; ca0[1] = na0[1]; ca1[0] = na1[0]; ca1[1] = na1[1]; }
            PG_LDA(At, 0, 1); PG_STAGE_B(PG_SB(0, 0), b2, k2b); PG_STAGE_B(PG_SB(0, 1), b2 + hstepB, k2b); PG_STAGE_A(PG_SA(0, 0), ca0, k2);
            PG_WAIT_V(8); PG_WAIT_L(0); PG_BAR; PG_MMA(1, 0, At, B0); PG_MMA(1, 1, At, B1); PG_BAR; PG_SCHED;
            PG_LDB(B0, 1, 0); PG_LDB(B1, 1, 1); PG_SCHED; PG_LDA(At, 1, 0); PG_STAGE_A(PG_SA(0, 1), ca1, k2);
            PG_WAIT_V(8); PG_WAIT_L(0); PG_BAR; PG_MMA(0, 0, At, B0); PG_MMA(0, 1, At, B1); PG_BAR; PG_SCHED;
            PG_LDA(At, 1, 1); PG_STAGE_B(PG_SB(1, 0), b2, k3b); PG_STAGE_B(PG_SB(1, 1), b2 + hstepB, k3b); PG_STAGE_A(PG_SA(1, 0), ca0, k3);
            PG_WAIT_V(8); PG_WAIT_L(0); PG_BAR; PG_MMA(1, 0, At, B0); PG_MMA(1, 1, At, B1); PG_BAR; PG_SCHED;
        }
        if constexpr (Op::FP8) asm volatile("s_nop 15\n\ts_nop 15\n\ts_nop 15\n\ts_nop 15" ::: "memory");
        if constexpr (Op::ALIGN) { if (wr == 0) PG_BAR; }
        { const int le_ = lane_id_fresh(); op.epi(acc, cur, wr, wc, le_ & 15, le_ >> 4); }
        if (!has_next) break;
#pragma unroll
        for (int a = 0; a < 2; ++a)
#pragma unroll
            for (int b = 0; b < 2; ++b)
#pragma unroll
                for (int m = 0; m < 4; ++m)
#pragma unroll
                    for (int n = 0; n < 2; ++n) acc[a][b][m][n] = (f32x4){0.f, 0.f, 0.f, 0.f};
        cur = nxt; cB = nB; ++ui;
        if constexpr (Op::ALIGN) { if (wr == 1) PG_BAR; }
    }
    PG_WAIT_V(0);
    if constexpr (!Op::ALIGN) { if (wr == 0) PG_BAR; }
    PG_BAR;
#undef PG_SA
#undef PG_SB
#undef PG_STAGE_A
#undef PG_STAGE_B
#undef PG_LDA
#undef PG_AOFF
#undef PG_LD8
#undef PG_LDB
#undef PG_MMA
#undef PG_WAIT_V
#undef PG_WAIT_L
#undef PG_BAR
#undef PG_SCHED
}
}


__device__ __forceinline__ void stage_store64(LAS unsigned char* slab, int fr, int fq, const f32x4 x00, const f32x4 x01, const f32x4 x10, const f32x4 x11, bf16_t* dst0, int ld) {
    LAS unsigned char* w = slab + fr * 144 + fq * 8;
    asm volatile("" ::: "memory");
    { u32x2 a; a.x = cvtpk(x00.x, x00.y); a.y = cvtpk(x00.z, x00.w); *(LAS u32x2*)(w) = a; }
    { u32x2 a; a.x = cvtpk(x01.x, x01.y); a.y = cvtpk(x01.z, x01.w); *(LAS u32x2*)(w + 32) = a; }
    { u32x2 a; a.x = cvtpk(x10.x, x10.y); a.y = cvtpk(x10.z, x10.w); *(LAS u32x2*)(w + 64) = a; }
    { u32x2 a; a.x = cvtpk(x11.x, x11.y); a.y = cvtpk(x11.z, x11.w); *(LAS u32x2*)(w + 96) = a; }
    asm volatile("" ::: "memory");
    const int lane = fq * 16 + fr, r8 = lane >> 3, p = lane & 7;
#pragma unroll
    for (int h = 0; h < 2; ++h) { const int row = r8 + 8 * h; const u32x4 v = *(const LAS u32x4*)(slab + row * 144 + p * 16); *(u32x4*)(dst0 + (size_t)row * ld + p * 8) = v; }
    asm volatile("" ::: "memory");
}
__device__ __forceinline__ void rope4(f32x4& x1, f32x4& x2, const f32x4 cs0, const f32x4 cs1) {
    const f32x4 cc = {cs0.x, cs0.z, cs1.x, cs1.z}, sn = {cs0.y, cs0.w, cs1.y, cs1.w};
    const f32x4 o1 = x1 * cc - x2 * sn, o2 = x2 * cc + x1 * sn; x1 = o1; x2 = o2;
}
template <bool F8>
struct OpIn {
    unsigned* sig = nullptr;
    __device__ __forceinline__ void pre_done(int wid) const { if (sig != nullptr && wid == 0 && lane_id_fresh() == 0) __hip_atomic_fetch_add(sig, 1u, __ATOMIC_RELAXED, __HIP_MEMORY_SCOPE_AGENT); }

    static constexpr int ROWB = F8 ? D : 2 * D, BROWB = ROWB, BKSTEP = 128; static constexpr bool FP8 = F8, ALIGN = true;
    const unsigned char* A; const unsigned char* Bt; int G, c;
    bf16_t *SQ, *SK, *SV, *RQ, *RK, *RV, *RGF, *RGB, *MQ, *CKV, *KF;
    const float* T32; const float* T16; float* SS;
    int off = 0, npn = INWP / 256, sel = 0;
    __device__ __forceinline__ bool next(int i, pg::Unit& u) const { u.e = 0; u.aux = 0; const bool ok = pg::tile_order((long)i * G + c + off, NROWS / 256, npn, u.pm, u.pn);
        if (ok) { if (sel == 1) u.pn = nth_bit(F8MASK | (F8N1 == 0), u.pn); else if (sel == 2) u.pn = nth_bit(BFMASK, u.pn); }
        return ok; }
    __device__ __forceinline__ const unsigned char* a_base() const { return A; }
    __device__ __forceinline__ void a_off(const pg::Unit& u, const int (&Rs)[2], const int (&Cs)[2], unsigned (&o0)[2], unsigned (&o1)[2]) const {
#pragma unroll
        for (int i = 0; i < 2; ++i) { o0[i] = (unsigned)((u.pm * 256 + Rs[i]) * ROWB + Cs[i] * 2); o1[i] = o0[i] + 128u * ROWB; }
    }
    __device__ __forceinline__ const unsigned char* b_base(const pg::Unit& u) const { return Bt + (size_t)u.pn * 256 * ROWB; }
    LAS unsigned char* slab;
    template <int MODE>
    __device__ __forceinline__ void epi_mode(const f32x4 (&acc)[2][2][4][2], bf16_t* dst, int ld, int col0, float scl, int part, bool isctx, int rowbase, int jbase, int wc, int fr, int fq) const {
#pragma unroll
        for (int ai = 0; ai < 2; ++ai)
#pragma unroll
            for (int m = 0; m < 4; ++m) {
                const int row0 = rowbase + ai * 128 + m * 16, j = jbase + ai * 128 + m * 16, t = j - NCTX;
                f32x4 x00 = acc[ai][0][m][0], x01 = acc[ai][0][m][1], x10 = acc[ai][1][m][0], x11 = acc[ai][1][m][1];
                if (F8) { x00 *= WSCALE_INV; x01 *= WSCALE_INV; x10 *= WSCALE_INV; x11 *= WSCALE_INV; }
                if (MODE == 1 || MODE == 2) {
                    const bool dorope = (MODE == 2) || !isctx; const int pos = (MODE == 2) ? j : (part ? (t & 63) : (t >> 6));
                    if (dorope) { const float* tab = T32 + ((size_t)pos * 32 + 4 * fq) * 2;
                        rope4(x00, x10, *(const f32x4*)tab, *(const f32x4*)(tab + 4)); rope4(x01, x11, *(const f32x4*)(tab + 32), *(const f32x4*)(tab + 36)); }
                    if (MODE == 2) { x00 *= scl; x01 *= scl; x10 *= scl; x11 *= scl; }
                } else if (MODE == 4 || MODE == 6) {
                    if (!isctx) { const float* tr_ = T16 + ((size_t)(t >> 6) * 16 + 4 * fq) * 2; const float* tc_ = T16 + ((size_t)(t & 63) * 16 + 4 * fq) * 2;
                        rope4(x00, x01, *(const f32x4*)tr_, *(const f32x4*)(tr_ + 4)); rope4(x10, x11, *(const f32x4*)tc_, *(const f32x4*)(tc_ + 4)); }
                } else if (MODE == 3) {
#pragma unroll
                    for (int e = 0; e < 4; ++e) { x00[e] = siluf(x00[e]); x01[e] = siluf(x01[e]); x10[e] = siluf(x10[e]); x11[e] = siluf(x11[e]); }
                } else if (MODE == 5) {
                    const f32x4 q = x00 * x00 + x01 * x01 + x10 * x10 + x11 * x11; float ss = (q.x + q.y) + (q.z + q.w);
                    ss += xor16_f(ss); ss = sum_xor32(ss);
                    if (fq == 0) { SS[(size_t)(row0 + fr) * 8 + wc] = ss; SS[(size_t)(row0 + fr) * 8 + 4 + wc] = 0.f; }
                }
                if (MODE == 6) {
#pragma unroll
                    for (int h = 0; h < 4; ++h) stage_store64(slab, fr, fq, x00, x01, x10, x11, dst + (size_t)row0 * 768 + h * 192 + 128, 768);
                } else stage_store64(slab, fr, fq, x00, x01, x10, x11, dst + (size_t)row0 * ld + col0, ld);
                __builtin_amdgcn_sched_barrier(0);
            }
    }
    __device__ __forceinline__ void epi(const f32x4 (&acc)[2][2][4][2], const pg::Unit& u, int wr, int wc, int fr, int fq) const {
        const int G64 = u.pn * 4 + wc;
        if (G64 >= 85) return;
        const int b = u.pm / 17, tile = u.pm - 17 * b; const bool isctx = (tile == 0);
        const int rowbase = u.pm * 256 + wr * 64, jbase = tile * 256 + wr * 64 + fr;
        if (G64 < 12)      epi_mode<1>(acc, SQ, 768, G64 * 64, 1.f, G64 & 1, isctx, rowbase, jbase, wc, fr, fq);
        else if (G64 < 16) epi_mode<1>(acc, SK, 256, (G64 - 12) * 64, 1.f, G64 & 1, isctx, rowbase, jbase, wc, fr, fq);
        else if (G64 < 20) epi_mode<0>(acc, SV, 256, (G64 - 16) * 64, 1.f, 0, isctx, rowbase, jbase, wc, fr, fq);
        else if (G64 < 26) epi_mode<2>(acc, RQ, 384, (G64 - 20) * 64, 0.125f, 0, isctx, rowbase, jbase, wc, fr, fq);
        else if (G64 < 32) epi_mode<2>(acc, RK, 384, (G64 - 26) * 64, 1.f, 0, isctx, rowbase, jbase, wc, fr, fq);
        else if (G64 < 44) epi_mode<0>(acc, RV, 768, (G64 - 32) * 64, 1.f, 0, isctx, rowbase, jbase, wc, fr, fq);
        else if (G64 < 56) epi_mode<3>(acc, RGF, 768, (G64 - 44) * 64, 1.f, 0, isctx, rowbase, jbase, wc, fr, fq);
        else if (G64 < 68) epi_mode<3>(acc, RGB, 768, (G64 - 56) * 64, 1.f, 0, isctx, rowbase, jbase, wc, fr, fq);
        else if (G64 < 80) { if ((G64 - 68) % 3 == 2) epi_mode<4>(acc, MQ, 768, (G64 - 68) * 64, 1.f, 0, isctx, rowbase, jbase, wc, fr, fq);
                             else epi_mode<0>(acc, MQ, 768, (G64 - 68) * 64, 1.f, 0, isctx, rowbase, jbase, wc, fr, fq); }
        else if (G64 < 84) epi_mode<5>(acc, CKV, 256, (G64 - 80) * 64, 1.f, 0, isctx, rowbase, jbase, wc, fr, fq);
        else               epi_mode<6>(acc, KF, 768, 128, 1.f, 0, isctx, rowbase, jbase, wc, fr, fq);
    }
};

struct OpKv {
    unsigned* sig = nullptr;
    __device__ __forceinline__ void pre_done(int wid) const { if (sig != nullptr && wid == 0 && lane_id_fresh() == 0) __hip_atomic_fetch_add(sig, 1u, __ATOMIC_RELAXED, __HIP_MEMORY_SCOPE_AGENT); }

    static constexpr int K = 256, ROWB = 512, BROWB = ROWB, BKSTEP = 128; static constexpr bool FP8 = false, ALIGN = true;
    const bf16_t* A; const bf16_t* Bt; int G, c; bf16_t* KF; bf16_t* MV; const float* SS;
    __device__ __forceinline__ bool next(int i, pg::Unit& u) const { u.e = 0; u.aux = 0; return pg::tile_order((long)i * G + c, NROWS / 256, 4, u.pm, u.pn); }
    __device__ __forceinline__ const bf16_t* a_base() const { return A; }
    __device__ __forceinline__ void a_off(const pg::Unit& u, const int (&Rs)[2], const int (&Cs)[2], unsigned (&o0)[2], unsigned (&o1)[2]) const {
#pragma unroll
        for (int i = 0; i < 2; ++i) { o0[i] = (unsigned)((u.pm * 256 + Rs[i]) * K + Cs[i]) * 2u; o1[i] = o0[i] + 128u * K * 2u; }
    }
    __device__ __forceinline__ const bf16_t* b_base(const pg::Unit& u) const { return Bt + (size_t)u.pn * 256 * K; }
    LAS unsigned char* slab;
    __device__ __forceinline__ void epi(const f32x4 (&acc)[2][2][4][2], const pg::Unit& u, int wr, int wc, int fr, int fq) const {
        const int rowbase = u.pm * 256 + wr * 64, head = (u.pn & 1) * 2 + (wc >> 1), d0 = (wc & 1) * 64;
#pragma unroll
        for (int ai = 0; ai < 2; ++ai)
#pragma unroll
            for (int m = 0; m < 4; ++m) {
                const int row0 = rowbase + ai * 128 + m * 16, row = row0 + fr;
                const f32x4 sa = *(const f32x4*)(SS + (size_t)row * 8), sb = *(const f32x4*)(SS + (size_t)row * 8 + 4);
                const float rs = __builtin_amdgcn_rsqf((((sa.x + sa.y) + (sa.z + sa.w)) + ((sb.x + sb.y) + (sb.z + sb.w))) * (1.f / 256.f) + LN_EPS);
                if (u.pn < 2) stage_store64(slab, fr, fq, acc[ai][0][m][0] * rs, acc[ai][0][m][1] * rs, acc[ai][1][m][0] * rs, acc[ai][1][m][1] * rs, KF + (size_t)row0 * 768 + head * 192 + d0, 768);
                else stage_store64(slab, fr, fq, acc[ai][0][m][0] * rs, acc[ai][0][m][1] * rs, acc[ai][1][m][0] * rs, acc[ai][1][m][1] * rs, MV + (size_t)row0 * 512 + head * 128 + d0, 512);
            }
    }
};

struct OpOut {
    unsigned* sig = nullptr;
    __device__ __forceinline__ void pre_done(int wid) const { if (sig != nullptr && wid == 0 && lane_id_fresh() == 0) __hip_atomic_fetch_add(sig, 1u, __ATOMIC_RELAXED, __HIP_MEMORY_SCOPE_AGENT); }

    static constexpr int K = D, ROWB = MK_OUT8 ? D : 2 * D, BROWB = ROWB, BKSTEP = 128; static constexpr bool FP8 = (MK_OUT8 != 0), ALIGN = true;
    const unsigned char* A; const unsigned char* Bt; int G, c; bf16_t* Y; int latent_only;
    __device__ __forceinline__ bool next(int i, pg::Unit& u) const { u.e = 0; u.aux = 0; int pm;
        const bool ok = pg::tile_order((long)i * G + c, latent_only ? 64 : 68, 8, pm, u.pn); u.pm = latent_only ? (pm >> 4) * 17 + 1 + (pm & 15) : pm; return ok; }
    __device__ __forceinline__ const unsigned char* a_base() const { return A; }
    __device__ __forceinline__ void a_off(const pg::Unit& u, const int (&Rs)[2], const int (&Cs)[2], unsigned (&o0)[2], unsigned (&o1)[2]) const {
#pragma unroll
        for (int i = 0; i < 2; ++i) { o0[i] = (unsigned)((u.pm * 256 + Rs[i]) * ROWB + Cs[i] * 2); o1[i] = o0[i] + 128u * ROWB; }
    }
    __device__ __forceinline__ const unsigned char* b_base(const pg::Unit& u) const { return Bt + (size_t)u.pn * 256 * ROWB; }
    LAS unsigned char* slab;
    __device__ __forceinline__ void epi(const f32x4 (&acc)[2][2][4][2], const pg::Unit& u, int wr, int wc, int fr, int fq) const {
        const int rowbase = u.pm * 256 + wr * 64, colbase = u.pn * 256 + 64 * wc;
#pragma unroll
        for (int ai = 0; ai < 2; ++ai)
#pragma unroll
            for (int m = 0; m < 4; ++m) { constexpr float sc_ = MK_OUT8 ? WSCALE_INV : 1.f;
                stage_store64(slab, fr, fq, acc[ai][0][m][0] * sc_, acc[ai][0][m][1] * sc_, acc[ai][1][m][0] * sc_, acc[ai][1][m][1] * sc_, Y + (size_t)(rowbase + ai * 128 + m * 16) * D + colbase, D); }
    }
};

struct MoeTab { const LAS int* cnt; const LAS int* tstart; const LAS unsigned char* tile_e; int T; };
__device__ __forceinline__ MoeTab moe_tables(const Frame& F, int l) {
    LAS int* cnt = (LAS int*)(F.lds + MISC_OFF + 64); LAS int* tstart = cnt + 32; LAS unsigned char* tile_e = (LAS unsigned char*)(tstart + 40);
    __syncthreads();
    if (F.tid < 32) cnt[F.tid] = (int)__hip_atomic_load(F.ctl + CW_CNT + 64 * l + F.tid, __ATOMIC_RELAXED, __HIP_MEMORY_SCOPE_AGENT);
    __syncthreads();
    if (F.tid == 0) { int s = 0; for (int e = 0; e < 32; ++e) { tstart[e] = s; s += (cnt[e] + 255) >> 8; } tstart[32] = s; }
    __syncthreads();
    const int T = tstart[32];
    for (int t = F.tid; t < T; t += NTHREADS) { int e = 0; while (tstart[e + 1] <= t) ++e; tile_e[t] = (unsigned char)e; }
    __syncthreads();
    MoeTab m; m.cnt = cnt; m.tstart = tstart; m.tile_e = tile_e; m.T = T; return m;
}

struct OpMoe1 {
    unsigned* sig = nullptr;
    __device__ __forceinline__ void pre_done(int wid) const { if (sig != nullptr && wid == 0 && lane_id_fresh() == 0) __hip_atomic_fetch_add(sig, 1u, __ATOMIC_RELAXED, __HIP_MEMORY_SCOPE_AGENT); }

    static constexpr int ROWB = D, BROWB = 128, BKSTEP = 256 * 128; static constexpr bool FP8 = true, ALIGN = true;
    const unsigned char* A; const unsigned char* Bt; int G, c; MoeTab tb; const int* LISTE; unsigned char* ACT;
    __device__ __forceinline__ bool next(int i, pg::Unit& u) const {
        const long L = (long)i * G + c; const int nwg = tb.T * 8; if (L >= nwg) return false;
        int wgid = (int)L; { const int q = nwg / 8, r = nwg % 8, xcd = wgid % 8, off = wgid / 8; wgid = (xcd < r ? xcd * (q + 1) : r * (q + 1) + (xcd - r) * q) + off; }
        const int ti = wgid >> 3; u.pn = wgid & 7; u.e = tb.tile_e[ti]; u.pm = ti; u.aux = ti - tb.tstart[u.e]; return true;
    }
    __device__ __forceinline__ const unsigned char* a_base() const { return A; }
    __device__ __forceinline__ void a_off(const pg::Unit& u, const int (&Rs)[2], const int (&Cs)[2], unsigned (&o0)[2], unsigned (&o1)[2]) const {
        const int n = tb.cnt[u.e]; const int* lst = LISTE + (size_t)u.e * NAID;
#pragma unroll
        for (int i = 0; i < 2; ++i) {
            const int p0 = u.aux * 256 + Rs[i], p1 = p0 + 128;
            const int r0 = (p0 < n) ? (lst[p0] >> 1) : 0, r1 = (p1 < n) ? (lst[p1] >> 1) : 0;
            o0[i] = (unsigned)(r0 * ROWB + Cs[i] * 2); o1[i] = (unsigned)(r1 * ROWB + Cs[i] * 2); }
    }
    __device__ __forceinline__ const unsigned char* b_base(const pg::Unit& u) const { return Bt + ((size_t)u.e * 2048 + (size_t)u.pn * 256) * ROWB; }
    __device__ __forceinline__ void epi(const f32x4 (&acc)[2][2][4][2], const pg::Unit& u, int wr, int wc, int fr, int fq) const {
        const int rowbase = u.pm * 256 + wr * 64 + fr, colbase = u.pn * 128 + 16 * wc + 4 * fq;
#pragma unroll
        for (int ai = 0; ai < 2; ++ai)
#pragma unroll
            for (int m = 0; m < 4; ++m) { unsigned char* p = ACT + (size_t)(rowbase + ai * 128 + m * 16) * EH + colbase;
#pragma unroll
                for (int bj = 0; bj < 2; ++bj) { const f32x4 g = acc[ai][bj][m][0] * WSCALE_INV, uu = acc[ai][bj][m][1] * WSCALE_INV; f32x4 o;
#pragma unroll
                    for (int e = 0; e < 4; ++e) o[e] = siluf(g[e]) * uu[e];
                    *(unsigned*)(p + bj * 64) = pk_fp8x4(o.x, o.y, o.z, o.w); } }
    }
};
struct OpMoe2 {
    unsigned* sig = nullptr;
    __device__ __forceinline__ void pre_done(int wid) const { if (sig != nullptr && wid == 0 && lane_id_fresh() == 0) __hip_atomic_fetch_add(sig, 1u, __ATOMIC_RELAXED, __HIP_MEMORY_SCOPE_AGENT); }

    static constexpr int ROWB = EH, BROWB = 128, BKSTEP = 256 * 128; static constexpr bool FP8 = true, ALIGN = true;
    const unsigned char* A; const unsigned char* Bt; int G, c; MoeTab tb; const int* LISTE; const float* AW; unsigned char* F2;
    __device__ __forceinline__ bool next(int i, pg::Unit& u) const {
        const long L = (long)i * G + c; const int nwg = tb.T * 8; if (L >= nwg) return false;
        int wgid = (int)L; { const int q = nwg / 8, r = nwg % 8, xcd = wgid % 8, off = wgid / 8; wgid = (xcd < r ? xcd * (q + 1) : r * (q + 1) + (xcd - r) * q) + off; }
        const int ti = wgid >> 3; u.pn = wgid & 7; u.e = tb.tile_e[ti]; u.pm = ti; u.aux = ti - tb.tstart[u.e]; return true;
    }
    __device__ __forceinline__ const unsigned char* a_base() const { return A; }
    __device__ __forceinline__ void a_off(const pg::Unit& u, const int (&Rs)[2], const int (&Cs)[2], unsigned (&o0)[2], unsigned (&o1)[2]) const {
#pragma unroll
        for (int i = 0; i < 2; ++i) { o0[i] = (unsigned)((u.pm * 256 + Rs[i]) * ROWB + Cs[i] * 2); o1[i] = o0[i] + 128u * ROWB; }
    }
    __device__ __forceinline__ const unsigned char* b_base(const pg::Unit& u) const { return Bt + ((size_t)u.e * 2048 + (size_t)u.pn * 256) * ROWB; }
    __device__ __forceinline__ void epi(const f32x4 (&acc)[2][2][4][2], const pg::Unit& u, int wr, int wc, int fr, int fq) const {
        const int n = tb.cnt[u.e]; const int* lst = LISTE + (size_t)u.e * NAID; const int colbase = u.pn * 256 + 32 * wc + 4 * fq;
        int aid[2][4]; float w[2][4];
#pragma unroll
        for (int ai = 0; ai < 2; ++ai)
#pragma unroll
            for (int m = 0; m < 4; ++m) { const int pos = u.aux * 256 + ai * 128 + wr * 64 + m * 16 + fr; aid[ai][m] = (pos < n) ? lst[pos] : -1;
                w[ai][m] = (pos < n) ? AW[(size_t)u.e * NAID + pos] * (WSCALE_INV * F2SCALE) : 0.f; }
#pragma unroll
        for (int ai = 0; ai < 2; ++ai)
#pragma unroll
            for (int m = 0; m < 4; ++m) {
                if (aid[ai][m] >= 0) { unsigned char* p = F2 + (size_t)aid[ai][m] * D + colbase; const float ww = w[ai][m];
#pragma unroll
                    for (int bj = 0; bj < 2; ++bj) { const f32x4 v0 = acc[ai][bj][m][0] * ww, v1 = acc[ai][bj][m][1] * ww;
                        *(unsigned*)(p + bj * 128) = pk_fp8x4(v0.x, v0.y, v0.z, v0.w); *(unsigned*)(p + bj * 128 + 16) = pk_fp8x4(v1.x, v1.y, v1.z, v1.w); } } }
    }
};

namespace att {
constexpr int V_BYTES = 16384, KM_BYTES = 16384, KR_BYTES = 8192;
constexpr int OFF_V = 0, OFF_KM = 2 * V_BYTES, OFF_KR = OFF_KM + 2 * KM_BYTES, OFF_WS = OFF_KR + 2 * KR_BYTES, LDS_TOTAL = OFF_WS + 8 * 256;
__device__ __forceinline__ int crow(int r, int hi) { return (r & 3) + 8 * (r >> 2) + 4 * hi; }
__device__ __forceinline__ int v_st(int k, int c) { const int kk = (k & ~0xC) | ((k & 4) << 1) | ((k & 8) >> 1); return ((kk >> 3) * 4 + (c >> 5)) * 512 + ((kk & 7) * 32 + (c & 31)) * 2; }
__device__ __forceinline__ int v_rd_base(int lane) { return ((lane & 3) << 3) | (((lane >> 2) & 3) << 6) | (((lane >> 4) & 1) << 5) | (((lane >> 5) & 1) << 8); }
constexpr int v_rd_off(int d0, int ks, int half) { return d0 * 512 + ks * 4096 + half * 2048; }
template <int OFF> __device__ __forceinline__ s16x4 tr_read(unsigned vb) { s16x4 r; asm volatile("ds_read_b64_tr_b16 %0, %1 offset:%2" : "=&v"(r) : "v"(vb), "i"(OFF) : "memory"); return r; }
#define ATT_PK(L, H) (bf16x8){L[0], L[1], L[2], L[3], H[0], H[1], H[2], H[3]}
template <int D0> __device__ __forceinline__ void pv_issue(unsigned vb, s16x4 (&l)[4], s16x4 (&h)[4]) {
    l[0] = tr_read<v_rd_off(D0, 0, 0)>(vb); h[0] = tr_read<v_rd_off(D0, 0, 1)>(vb); l[1] = tr_read<v_rd_off(D0, 1, 0)>(vb); h[1] = tr_read<v_rd_off(D0, 1, 1)>(vb);
    l[2] = tr_read<v_rd_off(D0, 2, 0)>(vb); h[2] = tr_read<v_rd_off(D0, 2, 1)>(vb); l[3] = tr_read<v_rd_off(D0, 3, 0)>(vb); h[3] = tr_read<v_rd_off(D0, 3, 1)>(vb);
}
__device__ __forceinline__ void pv_mma(f32x16& od, const s16x4 (&l)[4], const s16x4 (&h)[4], bf16x8 pa0, bf16x8 pa1, bf16x8 pa2, bf16x8 pa3) {
    od = __builtin_amdgcn_mfma_f32_32x32x16_bf16(pa0, ATT_PK(l[0], h[0]), od, 0, 0, 0);
    od = __builtin_amdgcn_mfma_f32_32x32x16_bf16(pa1, ATT_PK(l[1], h[1]), od, 0, 0, 0);
    od = __builtin_amdgcn_mfma_f32_32x32x16_bf16(pa2, ATT_PK(l[2], h[2]), od, 0, 0, 0);
    od = __builtin_amdgcn_mfma_f32_32x32x16_bf16(pa3, ATT_PK(l[3], h[3]), od, 0, 0, 0);
}

__device__ __forceinline__ void partialSM(f32x16& p0, f32x16& p1, float& m_reg, float& mn, float& alpha, float C, float thr_raw) {
    float pmax = p0[0];
#pragma unroll
    for (int r = 1; r < 16; ++r) pmax = fmaxf(pmax, p0[r]);
#pragma unroll
    for (int r = 0; r < 16; ++r) pmax = fmaxf(pmax, p1[r]);
    { auto sw = __builtin_amdgcn_permlane32_swap(__float_as_uint(pmax), __float_as_uint(pmax), false, false); pmax = fmaxf(__uint_as_float(sw[0]), __uint_as_float(sw[1])); }
    if (__builtin_expect(__all(pmax - m_reg <= thr_raw), 1)) { mn = m_reg; alpha = 1.f; }
    else { mn = fmaxf(m_reg, pmax); alpha = __builtin_amdgcn_exp2f((m_reg - mn) * C); m_reg = mn; }
    const float mnC = -mn * C;
#pragma unroll
    for (int r = 0; r < 16; ++r) { p0[r] = fmaf(p0[r], C, mnC); p1[r] = fmaf(p1[r], C, mnC); }
#pragma unroll
    for (int r = 0; r < 16; ++r) p0[r] = __builtin_amdgcn_exp2f(p0[r]);
}
__device__ __forceinline__ void finishSM(f32x16& p0, f32x16& p1, float alpha, float& l_reg, bf16x8& pa0, bf16x8& pa1, bf16x8& pa2, bf16x8& pa3) {
#pragma unroll
    for (int r = 0; r < 16; ++r) p1[r] = __builtin_amdgcn_exp2f(p1[r]);
    float ps = 0.f;
#pragma unroll
    for (int r = 0; r < 16; ++r) ps += p0[r];
#pragma unroll
    for (int r = 0; r < 16; ++r) ps += p1[r];
    { auto sw = __builtin_amdgcn_permlane32_swap(__float_as_uint(ps), __float_as_uint(ps), false, false); ps = __uint_as_float(sw[0]) + __uint_as_float(sw[1]); }
    l_reg = l_reg * alpha + ps;
#define ATT_PK4(P, BASE, OUT) do { const unsigned a0 = cvtpk(P[BASE + 0], P[BASE + 1]), a1 = cvtpk(P[BASE + 2], P[BASE + 3]); \
        const unsigned b0 = cvtpk(P[BASE + 4], P[BASE + 5]), b1 = cvtpk(P[BASE + 6], P[BASE + 7]); \
        auto r0 = __builtin_amdgcn_permlane32_swap(a0, b0, false, false); auto r1 = __builtin_amdgcn_permlane32_swap(a1, b1, false, false); \
        u32x4 w = {r0[0], r1[0], r0[1], r1[1]}; OUT = *reinterpret_cast<bf16x8*>(&w); } while (0)
    ATT_PK4(p0, 0, pa0); ATT_PK4(p0, 8, pa1); ATT_PK4(p1, 0, pa2); ATT_PK4(p1, 8, pa3);
#undef ATT_PK4
}
template <int DQK>
__device__ __forceinline__ void qkt(f32x16& p0, f32x16& p1, const LAS unsigned char* Km, const LAS unsigned char* Kr, const bf16x8* qr, int r32, int hi) {
#pragma unroll
    for (int r = 0; r < 16; ++r) { p0[r] = 0.f; p1[r] = 0.f; }
#pragma unroll
    for (int d0 = 0; d0 < 8; ++d0) { const int ch = 2 * d0 + hi;
        const bf16x8 b0 = *(const LAS bf16x8*)(Km + r32 * 256 + ((ch ^ (r32 & 15)) << 4));
        const bf16x8 b1 = *(const LAS bf16x8*)(Km + (32 + r32) * 256 + ((ch ^ (r32 & 15)) << 4));
        p0 = __builtin_amdgcn_mfma_f32_32x32x16_bf16(b0, qr[d0], p0, 0, 0, 0);
        p1 = __builtin_amdgcn_mfma_f32_32x32x16_bf16(b1, qr[d0], p1, 0, 0, 0); }
    if (DQK == 192) {
#pragma unroll
        for (int d0 = 8; d0 < DQK / 16; ++d0) { const int ch = 2 * (d0 - 8) + hi;
            const bf16x8 b0 = *(const LAS bf16x8*)(Kr + r32 * 128 + ((ch ^ ((r32 >> 1) & 7)) << 4));
            const bf16x8 b1 = *(const LAS bf16x8*)(Kr + (32 + r32) * 128 + ((ch ^ ((r32 >> 1) & 7)) << 4));
            p0 = __builtin_amdgcn_mfma_f32_32x32x16_bf16(b0, qr[d0], p0, 0, 0, 0);
            p1 = __builtin_amdgcn_mfma_f32_32x32x16_bf16(b1, qr[d0], p1, 0, 0, 0); }
    }
}
__device__ __forceinline__ void pv_tile(f32x16 (&o)[4], unsigned vb, bf16x8 pa0, bf16x8 pa1, bf16x8 pa2, bf16x8 pa3) {
    s16x4 vl0[4], vh0[4], vl1[4], vh1[4];
    pv_issue<0>(vb, vl0, vh0); pv_issue<1>(vb, vl1, vh1);
    asm volatile("s_waitcnt lgkmcnt(0)" ::: "memory"); __builtin_amdgcn_sched_barrier(0);
    pv_mma(o[0], vl0, vh0, pa0, pa1, pa2, pa3); pv_mma(o[1], vl1, vh1, pa0, pa1, pa2, pa3);
    pv_issue<2>(vb, vl0, vh0); pv_issue<3>(vb, vl1, vh1);
    asm volatile("s_waitcnt lgkmcnt(0)" ::: "memory"); __builtin_amdgcn_sched_barrier(0);
    pv_mma(o[2], vl0, vh0, pa0, pa1, pa2, pa3); pv_mma(o[3], vl1, vh1, pa0, pa1, pa2, pa3);
}

template <int DQK, bool WIN>
__device__ __forceinline__ void attn_unit(const bf16_t* __restrict__ Qp, int ldq, const bf16_t* __restrict__ Kp, int ldk, const bf16_t* __restrict__ Vp, int ldv, bf16_t* __restrict__ Op, int ldo,
                                          int nA, int nB, int kB0, int tq0, int tkB0, float m_init, float l_init, float C, float thr_raw, LAS unsigned char* lds, int wave_) {
    constexpr int ND = DQK / 16;
    const int lane = lane_id_fresh(), wid = wave_, r32 = lane & 31, hi = lane >> 5;
    LAS float* wsf = (LAS float*)(lds + OFF_WS) + wid * 64; LAS float* li_l = wsf; LAS float* al_l = wsf + 32;
    float m_reg = m_init, l_reg = l_init;
    f32x16 o[4];
#pragma unroll
    for (int d = 0; d < 4; ++d)
#pragma unroll
        for (int r = 0; r < 16; ++r) o[d][r] = 0.f;
    bf16x8 qr[ND];
    const bf16_t* Qw = Qp + (size_t)(wid * 32 + r32) * ldq + hi * 8;
#pragma unroll
    for (int d0 = 0; d0 < ND; ++d0) qr[d0] = *(const bf16x8*)(Qw + d0 * 16);
    unsigned okm[2], ov[2], okr;
#pragma unroll
    for (int i = 0; i < 2; ++i) { const int s_ = (2 * wid + i) * 64 + lane, row = s_ >> 4, lc = (s_ & 15) ^ (row & 15); okm[i] = (unsigned)(row * ldk + lc * 8) * 2u;
        const int sub = s_ >> 5, kk = ((sub >> 2) << 3) | ((s_ & 31) >> 2), key = (kk & ~0xC) | ((kk & 4) << 1) | ((kk & 8) >> 1), col = (sub & 3) * 32 + (s_ & 3) * 8;
        ov[i] = (unsigned)(key * ldv + col) * 2u; }
    { const int s_ = wid * 64 + lane, row = s_ >> 3, lc = (s_ & 7) ^ ((row >> 1) & 7); okr = (unsigned)(row * ldk + 128 + lc * 8) * 2u; }
    const unsigned vb0 = (unsigned)(size_t)(lds + OFF_V) + (unsigned)v_rd_base(lane);
    const int NT = nA + nB;
#define ATT_KROW(t) (((t) < nA) ? (t) * 64 : kB0 + ((t) - nA) * 64)
#define ATT_STAGE_K(t, b) do { const char* kg_ = (const char*)(Kp + (size_t)ATT_KROW(t) * ldk); \
        _Pragma("unroll") for (int i_ = 0; i_ < 2; ++i_) __builtin_amdgcn_global_load_lds((const unsigned*)(kg_ + okm[i_]), (LAS unsigned*)(lds + OFF_KM + (b) * KM_BYTES + (2 * wid + i_) * 1024), 16, 0, 0); \
        if (DQK == 192) __builtin_amdgcn_global_load_lds((const unsigned*)(kg_ + okr), (LAS unsigned*)(lds + OFF_KR + (b) * KR_BYTES + wid * 1024), 16, 0, 0); } while (0)
#define ATT_STAGE_V(t, b) do { const char* vg_ = (const char*)(Vp + (size_t)ATT_KROW(t) * ldv); \
        _Pragma("unroll") for (int i_ = 0; i_ < 2; ++i_) __builtin_amdgcn_global_load_lds((const unsigned*)(vg_ + ov[i_]), (LAS unsigned*)(lds + OFF_V + (b) * V_BYTES + (2 * wid + i_) * 1024), 16, 0, 0); } while (0)
#define ATT_QKT(P0, P1, t) qkt<DQK>(P0, P1, lds + OFF_KM + ((t) & 1) * KM_BYTES, lds + OFF_KR + ((t) & 1) * KR_BYTES, qr, r32, hi)
#define ATT_MASK(P0, P1, t) do { if (WIN && (t) >= nA) { const int dk_ = tkB0 + ((t) - nA) * 64 - (tq0 + wid * 32 + r32); \
        _Pragma("unroll") for (int r = 0; r < 16; ++r) { const int d0_ = dk_ + crow(r, hi), d1_ = d0_ + 32; \
            P0[r] = (d0_ >= -128 && d0_ <= 128) ? P0[r] : -1e30f; P1[r] = (d1_ >= -128 && d1_ <= 128) ? P1[r] : -1e30f; } } } while (0)
#define ATT_RESC(a) do { if (__any((a) < 1.f)) { if (hi == 0) al_l[r32] = (a); LDS_WAIT(); \
        _Pragma("unroll") for (int r = 0; r < 16; ++r) { const float a_ = al_l[crow(r, hi)]; _Pragma("unroll") for (int d = 0; d < 4; ++d) o[d][r] *= a_; } } } while (0)
#define ATT_SBAR() __builtin_amdgcn_sched_barrier(0)
    f32x16 pA0, pA1, pB0, pB1; float mnA, mnB, alA, alB; bf16x8 pa0, pa1, pa2, pa3;
    __syncthreads();
    ATT_STAGE_K(0, 0); VM_WAIT(); __syncthreads();
    ATT_STAGE_K(1, 1); ATT_STAGE_V(0, 0);
    ATT_QKT(pA0, pA1, 0); ATT_MASK(pA0, pA1, 0); partialSM(pA0, pA1, m_reg, mnA, alA, C, thr_raw);
    VM_WAIT(); __syncthreads();
    for (int j = 1; j + 1 < NT; j += 2) {
        ATT_STAGE_K(j + 1, 0); ATT_STAGE_V(j, 1);
        ATT_SBAR(); ATT_QKT(pB0, pB1, j); finishSM(pA0, pA1, alA, l_reg, pa0, pa1, pa2, pa3); ATT_SBAR();
        ATT_MASK(pB0, pB1, j);
        pv_tile(o, vb0, pa0, pa1, pa2, pa3); partialSM(pB0, pB1, m_reg, mnB, alB, C, thr_raw);
        VM_WAIT(); __syncthreads(); ATT_RESC(alB);
        ATT_STAGE_K(j + 2, 1); ATT_STAGE_V(j + 1, 0);
        ATT_SBAR(); ATT_QKT(pA0, pA1, j + 1); finishSM(pB0, pB1, alB, l_reg, pa0, pa1, pa2, pa3); ATT_SBAR();
        ATT_MASK(pA0, pA1, j + 1);
        pv_tile(o, vb0 + (unsigned)V_BYTES, pa0, pa1, pa2, pa3); partialSM(pA0, pA1, m_reg, mnA, alA, C, thr_raw);
        VM_WAIT(); __syncthreads(); ATT_RESC(alA);
    }
    ATT_STAGE_V(NT - 1, 1);
    ATT_SBAR(); ATT_QKT(pB0, pB1, NT - 1); finishSM(pA0, pA1, alA, l_reg, pa0, pa1, pa2, pa3); ATT_SBAR();
    ATT_MASK(pB0, pB1, NT - 1);
    pv_tile(o, vb0, pa0, pa1, pa2, pa3); partialSM(pB0, pB1, m_reg, mnB, alB, C, thr_raw);
    VM_WAIT(); __syncthreads(); ATT_RESC(alB);
    finishSM(pB0, pB1, alB, l_reg, pa0, pa1, pa2, pa3); ATT_SBAR();
    pv_tile(o, vb0 + (unsigned)V_BYTES, pa0, pa1, pa2, pa3);
    if (hi == 0) li_l[r32] = l_reg;
    LDS_WAIT();
    bf16_t* Ow = Op + (size_t)(wid * 32) * ldo;
    if (MK_OUT8) {
        unsigned char* O8 = (unsigned char*)Op + (size_t)(wid * 32) * ldo + (r32 & ~3);
        const int q_ = r32 & 3; const bool b_ = (q_ & 1) != 0, c_ = (q_ & 2) != 0;
#pragma unroll
        for (int g = 0; g < 4; ++g) {
            const int rowq = q_ + 8 * g + 4 * hi;
            const float l0 = __builtin_amdgcn_rcpf(li_l[8 * g + 4 * hi]), l1 = __builtin_amdgcn_rcpf(li_l[8 * g + 4 * hi + 1]), l2 = __builtin_amdgcn_rcpf(li_l[8 * g + 4 * hi + 2]), l3 = __builtin_amdgcn_rcpf(li_l[8 * g + 4 * hi + 3]);
#pragma unroll
            for (int d0 = 0; d0 < 4; ++d0) {
                const float x0 = o[d0][4 * g] * l0, x1 = o[d0][4 * g + 1] * l1, x2 = o[d0][4 * g + 2] * l2, x3 = o[d0][4 * g + 3] * l3;
                const float r0 = dpp_f<0xB1>(b_ ? x0 : x1), r1 = dpp_f<0xB1>(b_ ? x2 : x3);
                const float Alo = b_ ? r0 : x0, Ahi = b_ ? x1 : r0, Blo = b_ ? r1 : x2, Bhi = b_ ? x3 : r1;
                const float s0 = dpp_f<0x4E>(c_ ? Alo : Blo), s1 = dpp_f<0x4E>(c_ ? Ahi : Bhi);
                const float Klo = c_ ? Blo : Alo, Khi = c_ ? Bhi : Ahi;
                const unsigned w = c_ ? pk_fp8x4(s0, s1, Klo, Khi) : pk_fp8x4(Klo, Khi, s0, s1);
                *(unsigned*)(O8 + (size_t)rowq * ldo + d0 * 32) = w; } }
    } else {
#pragma unroll
    for (int r = 0; r < 16; ++r) { const int orow = crow(r, hi); const float rl = __builtin_amdgcn_rcpf(li_l[orow]);
#pragma unroll
        for (int d0 = 0; d0 < 4; ++d0) Ow[(size_t)orow * ldo + d0 * 32 + r32] = (bf16_t)(cvtpk(o[d0][r] * rl, 0.f) & 0xffffu); }
    }
#undef ATT_KROW
#undef ATT_STAGE_K
#undef ATT_STAGE_V
#undef ATT_QKT
#undef ATT_MASK
#undef ATT_RESC
#undef ATT_SBAR
}
}

namespace ret {
__device__ __forceinline__ int bwd_chunk_of_block(int blk) { return blk == 1 ? 0 : (blk == 0 ? 1 : 35 - blk); }
__device__ __forceinline__ float log2_gamma(const float* ret_decay, int l, int dir, int h) { const float p = ret_decay[(l * 2 + dir) * 6 + h]; return __log2f(1.f - exp2f(-p)); }
__device__ __forceinline__ s16x4 tr16(unsigned addr) { s16x4 r; asm volatile("ds_read_b64_tr_b16 %0, %1" : "=&v"(r) : "v"(addr) : "memory"); return r; }
__device__ __forceinline__ void tr_frag_issue(unsigned base, int S, int ks, int col0, int lane, s16x4& lo, s16x4& hi) {
    const int g = lane >> 4, q = (lane & 15) >> 2, p = lane & 3;
    const unsigned a = base + (unsigned)((32 * ks + 8 * g + q) * S + (col0 + 4 * p) * 2);
    lo = tr16(a); hi = tr16(a + 4u * (unsigned)S);
}
#define RET_PK(L, H) (bf16x8){L[0], L[1], L[2], L[3], H[0], H[1], H[2], H[3]}
constexpr int SV = 272, SK = 144;

__device__ __forceinline__ int chain_block(int dir, int n) { return dir ? (n == 0 ? 1 : (n == 1 ? 0 : 35 - n)) : n; }
__device__ __forceinline__ void chain_unit(const Frame& F, const Params& P, int l, int u) {
    const int dir = u / 24, b = (u % 24) / 6, h = u % 6;
    const bf16_t* RK = (const bf16_t*)(F.ws + WS_RK); const bf16_t* RV = (const bf16_t*)(F.ws + WS_RV); bf16_t* SP = (bf16_t*)(F.ws + WS_SPREV);
    const float lg = log2_gamma(P.in[I_RDEC], l, dir, h), dec = __builtin_amdgcn_exp2f(128.f * lg);
    constexpr int BUFB = 128 * SK + 128 * SV;
    const int g = F.lane >> 4, l16 = F.lane & 15, dv0 = 16 * F.wave;
    f32x4 acc[4];
#pragma unroll
    for (int n = 0; n < 4; ++n) acc[n] = (f32x4){0.f, 0.f, 0.f, 0.f};
    u32x4 kreg[2], vreg[4];
#define CH_LOAD(n_) do { const int r0_ = b * TPB + chain_block(dir, (n_)) * 128; \
        _Pragma("unroll") for (int i = 0; i < 2; ++i) { const int c = F.tid + 512 * i; kreg[i] = *(const u32x4*)(RK + (size_t)(r0_ + (c >> 3)) * 384 + h * 64 + (c & 7) * 8); } \
        _Pragma("unroll") for (int i = 0; i < 4; ++i) { const int c = F.tid + 512 * i; vreg[i] = *(const u32x4*)(RV + (size_t)(r0_ + (c >> 4)) * 768 + h * 128 + (c & 15) * 8); } } while (0)
#define CH_WRITE(buf_) do { LAS unsigned char* kb_ = F.lds + (buf_) * BUFB; LAS unsigned char* vb_ = kb_ + 128 * SK; \
        _Pragma("unroll") for (int i = 0; i < 2; ++i) { const int c = F.tid + 512 * i, row = c >> 3, ch = c & 7; \
            const float w_ = __builtin_amdgcn_exp2f(lg * (float)(dir ? row : 127 - row)); u32x4 o_; \
            _Pragma("unroll") for (int e = 0; e < 4; ++e) o_[e] = cvtpk(bflo(kreg[i][e]) * w_, bfhi(kreg[i][e]) * w_); \
            *(LAS u32x4*)(kb_ + row * SK + ch * 16) = o_; } \
        _Pragma("unroll") for (int i = 0; i < 4; ++i) { const int c = F.tid + 512 * i; *(LAS u32x4*)(vb_ + (c >> 4) * SV + (c & 15) * 16) = vreg[i]; } } while (0)
    __syncthreads();
    CH_LOAD(0); CH_WRITE(0); __syncthreads();
#pragma unroll 1
    for (int n = 0; n < 34; ++n) {
        if (n + 1 < 34) CH_LOAD(n + 1);
        bf16_t* dst = SP + ((size_t)u * 34 + n) * 8192;
#pragma unroll
        for (int n4 = 0; n4 < 4; ++n4) {
#pragma unroll
            for (int rg = 0; rg < 4; ++rg) dst[(dv0 + 4 * g + rg) * 64 + 16 * n4 + l16] = (bf16_t)(cvtpk(acc[n4][rg], 0.f) & 0xffffu);
            acc[n4] *= dec; }
        const unsigned kbase = (unsigned)(size_t)(F.lds + (n & 1) * BUFB), vbase = kbase + 128 * SK;
        {
            s16x4 al[4], ah[4], fl[4][4], fh[4][4];
#pragma unroll
            for (int ks = 0; ks < 4; ++ks) { tr_frag_issue(vbase, SV, ks, dv0, F.lane, al[ks], ah[ks]);
#pragma unroll
                for (int n4 = 0; n4 < 4; ++n4) tr_frag_issue(kbase, SK, ks, 16 * n4, F.lane, fl[ks][n4], fh[ks][n4]); }
            asm volatile("s_waitcnt lgkmcnt(0)" ::: "memory"); __builtin_amdgcn_sched_barrier(0);
#pragma unroll
            for (int ks = 0; ks < 4; ++ks) { const bf16x8 a = RET_PK(al[ks], ah[ks]);
#pragma unroll
                for (int n4 = 0; n4 < 4; ++n4) acc[n4] = __builtin_amdgcn_mfma_f32_16x16x32_bf16(a, RET_PK(fl[ks][n4], fh[ks][n4]), acc[n4], 0, 0, 0); }
        }
        if (n + 1 < 34) CH_WRITE((n + 1) & 1);
        __syncthreads();
    }
#undef CH_LOAD
#undef CH_WRITE
}

__device__ __forceinline__ void rc_unit(const Frame& F, const Params& P, int l, int u) {
    const int b = u / (6 * 34), rem = u % (6 * 34), h = rem / 34, blk = rem % 34;
    const bf16_t* RQ = (const bf16_t*)(F.ws + WS_RQ); const bf16_t* RK = (const bf16_t*)(F.ws + WS_RK); const bf16_t* RV = (const bf16_t*)(F.ws + WS_RV);
    const bf16_t* RGF = (const bf16_t*)(F.ws + WS_RGF); const bf16_t* RGB = (const bf16_t*)(F.ws + WS_RGB); const bf16_t* SP = (const bf16_t*)(F.ws + WS_SPREV);
    bf16_t* MIX = (bf16_t*)(F.ws + WS_MIX);
    const int r0 = b * TPB + blk * 128;
    const float lgf = log2_gamma(P.in[I_RDEC], l, 0, h), lgb = log2_gamma(P.in[I_RDEC], l, 1, h);
    LAS unsigned char* Vl = F.lds; LAS unsigned char* Pf = F.lds + 128 * SV + F.wave * (2 * 16 * SV); LAS unsigned char* Pb = Pf + 16 * SV;
    const int g = F.lane >> 4, l16 = F.lane & 15, q0 = 16 * F.wave;
    __syncthreads();
#pragma unroll
    for (int i = 0; i < 4; ++i) { const int c = F.tid + 512 * i, row = c >> 4, ch = c & 15;
        *(LAS u32x4*)(Vl + row * SV + ch * 16) = *(const u32x4*)(RV + (size_t)(r0 + row) * 768 + h * 128 + ch * 8); }
    __syncthreads();
    bf16x8 qf[2];
#pragma unroll
    for (int ks = 0; ks < 2; ++ks) qf[ks] = *(const bf16x8*)(RQ + (size_t)(r0 + q0 + l16) * 384 + h * 64 + 32 * ks + 8 * g);
    f32x4 acc[2][8];
#pragma unroll
    for (int d = 0; d < 2; ++d)
#pragma unroll
        for (int n = 0; n < 8; ++n) acc[d][n] = (f32x4){0.f, 0.f, 0.f, 0.f};
#pragma unroll
    for (int d = 0; d < 2; ++d) { const int chunk = d ? bwd_chunk_of_block(blk) : blk;
        const bf16_t* st = SP + ((((size_t)d * 4 + b) * 6 + h) * 34 + chunk) * 8192 + l16 * 64 + 8 * g;
        bf16x8 sf[8][2];
#pragma unroll
        for (int n = 0; n < 8; ++n)
#pragma unroll
            for (int ks = 0; ks < 2; ++ks) sf[n][ks] = *(const bf16x8*)(st + n * 1024 + 32 * ks);
#pragma unroll
        for (int n = 0; n < 8; ++n)
#pragma unroll
            for (int ks = 0; ks < 2; ++ks) acc[d][n] = __builtin_amdgcn_mfma_f32_16x16x32_bf16(sf[n][ks], qf[ks], acc[d][n], 0, 0, 0);
        __builtin_amdgcn_sched_barrier(0); }
    {
        const int i = q0 + l16; const float ff = __builtin_amdgcn_exp2f(lgf * (float)(i + 1)), fb = __builtin_amdgcn_exp2f(lgb * (float)(128 - i));
#pragma unroll
        for (int n = 0; n < 8; ++n) { acc[0][n] *= ff; acc[1][n] *= fb; }
    }
    {
        const int i = q0 + l16;
        const bf16_t* kp = RK + (size_t)(r0 + l16) * 384 + h * 64 + 8 * g;
        bf16x8 kf[8][2];
#pragma unroll
        for (int mt = 0; mt < 8; ++mt)
#pragma unroll
            for (int ks = 0; ks < 2; ++ks) kf[mt][ks] = *(const bf16x8*)(kp + mt * (16 * 384) + 32 * ks);
#pragma unroll
        for (int mt = 0; mt < 8; ++mt) { f32x4 s = {0.f, 0.f, 0.f, 0.f};
#pragma unroll
            for (int ks = 0; ks < 2; ++ks) s = __builtin_amdgcn_mfma_f32_16x16x32_bf16(kf[mt][ks], qf[ks], s, 0, 0, 0);
            f32x4 pf, pb;
#pragma unroll
            for (int rg = 0; rg < 4; ++rg) { const int d = i - (16 * mt + 4 * g + rg);
                pf[rg] = d >= 0 ? s[rg] * __builtin_amdgcn_exp2f(lgf * (float)d) : 0.f; pb[rg] = d <= 0 ? s[rg] * __builtin_amdgcn_exp2f(-lgb * (float)d) : 0.f; }
            u32x2 wf, wb; wf.x = cvtpk(pf.x, pf.y); wf.y = cvtpk(pf.z, pf.w); wb.x = cvtpk(pb.x, pb.y); wb.y = cvtpk(pb.z, pb.w);
            *(LAS u32x2*)(Pf + l16 * SV + (16 * mt + 4 * g) * 2) = wf; *(LAS u32x2*)(Pb + l16 * SV + (16 * mt + 4 * g) * 2) = wb; }
    }
    LDS_WAIT(); __builtin_amdgcn_sched_barrier(0);
    const unsigned vbase = (unsigned)(size_t)Vl;
#pragma unroll 1
    for (int ks = 0; ks < 4; ++ks) {
        const bool dof = (32 * ks <= q0 + 15), dob = (32 * ks + 31 >= q0);
        const bf16x8 af = *(const LAS bf16x8*)(Pf + l16 * SV + (32 * ks + 8 * g) * 2), ab = *(const LAS bf16x8*)(Pb + l16 * SV + (32 * ks + 8 * g) * 2);
        s16x4 vl[8], vh[8];
#pragma unroll
        for (int n = 0; n < 8; ++n) tr_frag_issue(vbase, SV, ks, 16 * n, F.lane, vl[n], vh[n]);
        asm volatile("s_waitcnt lgkmcnt(0)" ::: "memory"); __builtin_amdgcn_sched_barrier(0);
        if (dof) {
#pragma unroll
            for (int n = 0; n < 8; ++n) acc[0][n] = __builtin_amdgcn_mfma_f32_16x16x32_bf16(RET_PK(vl[n], vh[n]), af, acc[0][n], 0, 0, 0); }
        if (dob) {
#pragma unroll
            for (int n = 0; n < 8; ++n) acc[1][n] = __builtin_amdgcn_mfma_f32_16x16x32_bf16(RET_PK(vl[n], vh[n]), ab, acc[1][n], 0, 0, 0); }
    }
    {
        const int row = r0 + q0 + l16;
        float mean[2], rstd[2];
#pragma unroll
        for (int d = 0; d < 2; ++d) { float s_ = 0.f;
#pragma unroll
            for (int n = 0; n < 8; ++n) s_ += (acc[d][n].x + acc[d][n].y) + (acc[d][n].z + acc[d][n].w);
            s_ += xor16_f(s_); s_ = sum_xor32(s_);
            const float mu = s_ * (1.f / 128.f); float v_ = 0.f;
#pragma unroll
            for (int n = 0; n < 8; ++n) { const f32x4 x = acc[d][n] - mu; v_ += (x.x * x.x + x.y * x.y) + (x.z * x.z + x.w * x.w); }
            v_ += xor16_f(v_); v_ = sum_xor32(v_);
            mean[d] = mu; rstd[d] = __builtin_amdgcn_rsqf(v_ * (1.f / 128.f) + LN_EPS); }
        const bf16_t* gf = RGF + (size_t)row * 768 + h * 128 + 4 * g; const bf16_t* gb = RGB + (size_t)row * 768 + h * 128 + 4 * g;
        bf16_t* o = MIX + (size_t)row * D + 768 + h * 128 + 4 * g; unsigned char* o8 = (unsigned char*)(F.ws + WS_MIX8) + (size_t)row * D + 768 + h * 128 + 4 * g;
#pragma unroll
        for (int n = 0; n < 8; ++n) { const u32x2 a = *(const u32x2*)(gf + 16 * n), bb = *(const u32x2*)(gb + 16 * n);
            const f32x4 ga = {bflo(a.x), bfhi(a.x), bflo(a.y), bfhi(a.y)}, gbv = {bflo(bb.x), bfhi(bb.x), bflo(bb.y), bfhi(bb.y)};
            const f32x4 y = ga * ((acc[0][n] - mean[0]) * rstd[0]) + gbv * ((acc[1][n] - mean[1]) * rstd[1]);
            if (MK_OUT8) *(unsigned*)(o8 + 16 * n) = pk_fp8x4(y.x, y.y, y.z, y.w); else st8(o + 16 * n, y); }
    }
}
#undef RET_PK
}

constexpr float LOG2E = 1.4426950408889634f;
__device__ __forceinline__ void swa_units(const Frame& F, const Params& P, int l, int G2, int c2, int sigslot) {
    const bf16_t* SQ = (const bf16_t*)(F.ws + WS_SQ); const bf16_t* SK = (const bf16_t*)(F.ws + WS_SK); const bf16_t* SV = (const bf16_t*)(F.ws + WS_SV); bf16_t* MIX = (bf16_t*)(F.ws + WS_MIX);
    constexpr float scale = 0.08838834764831845f;
    const int NU = (l == DEPTH - 1) ? 384 : 408;
    bool sent = false;
    for (int u = G2 - 1 - c2; u < NU; u += G2) {
        int b, hq, row0, nB = 0, kB0 = 0, tq0 = 0, tkB0 = 0;
        if (u < 384) { b = u / 96; const int rem = u % 96; hq = rem >> 4; const int qb = rem & 15; row0 = b * TPB + NCTX + 256 * qb;
            const int lo = (256 * qb - 128 > 0) ? 256 * qb - 128 : 0, hi = (256 * qb + 384 < SEQ) ? 256 * qb + 384 : SEQ; nB = (hi - lo) >> 6; kB0 = NCTX + lo; tq0 = 256 * qb; tkB0 = lo; }
        else { const int v = u - 384; b = v / 6; hq = v % 6; row0 = b * TPB; }
        if (sigslot >= 0 && u + G2 >= NU) { conv_signal(F, sigslot); sent = true; }
        const float sink = P.in[I_SINK][l * 6 + hq];
        att::attn_unit<128, true>(SQ + (size_t)row0 * 768 + hq * 128, 768, SK + (size_t)b * TPB * 256 + (hq / 3) * 128, 256, SV + (size_t)b * TPB * 256 + (hq / 3) * 128, 256,
                                  MK_OUT8 ? (bf16_t*)((unsigned char*)(F.ws + WS_MIX8) + (size_t)row0 * D + hq * 128) : MIX + (size_t)row0 * D + hq * 128, D, 4, nB, kB0, tq0, tkB0, sink / scale, 1.f, scale * LOG2E, 8.f / scale, F.lds, F.wave);
    }
    if (sigslot >= 0 && !sent) conv_signal(F, sigslot);
}
__device__ __forceinline__ void mla_units(const Frame& F, const Params& P, int l) {
    const bf16_t* MQ = (const bf16_t*)(F.ws + WS_MQ); const bf16_t* KF = (const bf16_t*)(F.ws + WS_KF); const bf16_t* MV = (const bf16_t*)(F.ws + WS_MV); bf16_t* MIX = (bf16_t*)(F.ws + WS_MIX);
    constexpr float scale = 0.07216878364870323f;
    const int NU = (l == DEPTH - 1) ? 256 : 272;
    for (int u = F.G - 1 - F.bx; u < NU; u += F.G) {
        int b, h, row0, nA;
        if (u < 256) { b = u >> 6; h = (u >> 4) & 3; row0 = b * TPB + NCTX + 256 * (u & 15); nA = TPB / 64; }
        else { const int v = u - 256; b = v >> 2; h = v & 3; row0 = b * TPB; nA = NCTX / 64; }
        att::attn_unit<192, false>(MQ + (size_t)row0 * 768 + h * 192, 768, KF + (size_t)b * TPB * 768 + h * 192, 768, MV + (size_t)b * TPB * 512 + h * 128, 512,
                                   MK_OUT8 ? (bf16_t*)((unsigned char*)(F.ws + WS_MIX8) + (size_t)row0 * D + 1536 + h * 128) : MIX + (size_t)row0 * D + 1536 + h * 128, D, nA, 0, 0, 0, 0, -1e30f, 0.f, scale * LOG2E, 8.f / scale, F.lds, F.wave);
    }
}

constexpr int N_PHASES = 2 + 8 * DEPTH;
__global__ void __launch_bounds__(NTHREADS, 2) hybrid_dit_fwd(Params P) {
    extern __shared__ __attribute__((aligned(16))) unsigned char lds_raw[];
    Frame F0;
    F0.lds = (LAS unsigned char*)lds_raw; F0.ws = P.ws; F0.ctl = (unsigned*)(P.ws + WS_CTL);
    F0.tid = threadIdx.x; F0.lane = F0.tid & 63; F0.wave = __builtin_amdgcn_readfirstlane(F0.tid >> 6); F0.G = gridDim.x; F0.bx = blockIdx.x;
    __builtin_assume(F0.bx >= 0 && F0.bx < 256 && F0.G >= 1 && F0.G <= 256);
    volatile LAS unsigned* misc = (volatile LAS unsigned*)(F0.lds + MISC_OFF);
    if (F0.tid < 4) misc[F0.tid] = 0u;
    __syncthreads();
#if MK_PER_PHASE
#define GRID_BAR() do { } while (0)
#else
    XcdBarrier bar = xcd_barrier_post(F0.ctl + CW_BAR, misc);
#define GRID_BAR() xcd_barrier(bar, F0.wave)
#endif
#if MK_PER_PHASE
    const int lo = P.ph_lo, hi = P.ph_hi;
#else
    constexpr int lo = 0, hi = N_PHASES;
#endif
#define IN(k) (lo <= (k) && (k) < hi)
#define SEAM(k) do { if (IN(k) && IN((k) + 1)) GRID_BAR(); } while (0)
    if (IN(0) && PHEN(0)) { _Pragma("unroll 1") for (int rep_ = 0; rep_ < NREP(0); ++rep_) { if (rep_) GRID_BAR(); const Frame F = fresh_frame(F0); p0_prologue(F, P); } } SEAM(0);
    if (IN(1) && PHEN(1)) { _Pragma("unroll 1") for (int rep_ = 0; rep_ < NREP(1); ++rep_) { if (rep_) GRID_BAR(); const Frame F = fresh_frame(F0); phase_r1(F, P); } } SEAM(1);
#pragma unroll 1
    for (int l = 0; l < DEPTH; ++l) {
        const int pb = 2 + 8 * l;
        if (IN(pb + 0) && PHEN(2)) {
            const Frame F = fresh_frame(F0);
            const bool split = (F.G == 256) && (l == 0 || conv_remaining(F) > 0); const int ncomp = split ? F.G - NCONV : F.G;
            if (split && F.bx >= ncomp) converter_slot(F, P, l == 0 ? 0 : 4, 0, ncomp);
            else if (l == 0) {
                int off2 = 0;
                if (MK_F8SEL) {
                    constexpr int U1 = (NROWS / 256) * F8N1;
                    OpIn<true> o8; o8.A = (const unsigned char*)(F.ws + WS_H8); o8.Bt = (const unsigned char*)(F.ws + WS_WIN) + (size_t)INWP * D * 3; o8.G = ncomp; o8.c = F.bx; o8.npn = F8N1; o8.sel = 1;
                    o8.SQ = (bf16_t*)(F.ws + WS_SQ); o8.SK = (bf16_t*)(F.ws + WS_SK); o8.SV = (bf16_t*)(F.ws + WS_SV); o8.RQ = (bf16_t*)(F.ws + WS_RQ); o8.RK = (bf16_t*)(F.ws + WS_RK);
                    o8.RV = (bf16_t*)(F.ws + WS_RV); o8.RGF = (bf16_t*)(F.ws + WS_RGF); o8.RGB = (bf16_t*)(F.ws + WS_RGB); o8.MQ = (bf16_t*)(F.ws + WS_MQ); o8.CKV = (bf16_t*)(F.ws + WS_CKV);
                    o8.KF = (bf16_t*)(F.ws + WS_KF); o8.T32 = (const float*)(F.ws + WS_T32); o8.T16 = (const float*)(F.ws + WS_T16); o8.SS = (float*)(F.ws + WS_SSP);
                    o8.slab = F.lds + EPI_OFF + F.wave * EPI_SLAB; pg::gemm_phase<OpIn<true>>(F.lds, o8, F.wave);
                    off2 = ((U1 - F.bx + ncomp - 1) / ncomp) * ncomp - U1;
                }
                OpIn<false> op; op.off = off2; if (MK_F8SEL) { op.npn = INWP / 256 - F8N1; op.sel = 2; } op.A = (const unsigned char*)(F.ws + WS_H); op.Bt = (const unsigned char*)(F.ws + WS_WIN); op.G = ncomp; op.c = F.bx;
                op.SQ = (bf16_t*)(F.ws + WS_SQ); op.SK = (bf16_t*)(F.ws + WS_SK); op.SV = (bf16_t*)(F.ws + WS_SV); op.RQ = (bf16_t*)(F.ws + WS_RQ); op.RK = (bf16_t*)(F.ws + WS_RK);
                op.RV = (bf16_t*)(F.ws + WS_RV); op.RGF = (bf16_t*)(F.ws + WS_RGF); op.RGB = (bf16_t*)(F.ws + WS_RGB); op.MQ = (bf16_t*)(F.ws + WS_MQ); op.CKV = (bf16_t*)(F.ws + WS_CKV);
                op.KF = (bf16_t*)(F.ws + WS_KF); op.T32 = (const float*)(F.ws + WS_T32); op.T16 = (const float*)(F.ws + WS_T16); op.SS = (float*)(F.ws + WS_SSP);
                op.slab = F.lds + EPI_OFF + F.wave * EPI_SLAB; if (split) op.sig = F.ctl + CW_CONV + 64 * (1 + 0); pg::gemm_phase<OpIn<false>>(F.lds, op, F.wave);
            } else {
                OpIn<true> op; op.A = (const unsigned char*)(F.ws + WS_H8); op.Bt = (const unsigned char*)(F.ws + WS_WIN) + (size_t)INWP * D * 2; op.G = ncomp; op.c = F.bx;
                op.SQ = (bf16_t*)(F.ws + WS_SQ); op.SK = (bf16_t*)(F.ws + WS_SK); op.SV = (bf16_t*)(F.ws + WS_SV); op.RQ = (bf16_t*)(F.ws + WS_RQ); op.RK = (bf16_t*)(F.ws + WS_RK);
                op.RV = (bf16_t*)(F.ws + WS_RV); op.RGF = (bf16_t*)(F.ws + WS_RGF); op.RGB = (bf16_t*)(F.ws + WS_RGB); op.MQ = (bf16_t*)(F.ws + WS_MQ); op.CKV = (bf16_t*)(F.ws + WS_CKV);
                op.KF = (bf16_t*)(F.ws + WS_KF); op.T32 = (const float*)(F.ws + WS_T32); op.T16 = (const float*)(F.ws + WS_T16); op.SS = (float*)(F.ws + WS_SSP);
                op.slab = F.lds + EPI_OFF + F.wave * EPI_SLAB; if (split) op.sig = F.ctl + CW_CONV + 64 * (1 + 4); pg::gemm_phase<OpIn<true>>(F.lds, op, F.wave);
            }
        }
        SEAM(pb + 0);
        if (IN(pb + 1)) {
            const Frame F = fresh_frame(F0);
            const int NCH = (F.G >= 96) ? 48 : 0;
            if (NCH) { if (F.bx < NCH) ret::chain_unit(F, P, l, F.bx); }
            else { for (int u = F.bx; u < 48; u += F.G) ret::chain_unit(F, P, l, u); }
            const bool split = (F.G == 256) && (l == 0 || conv_remaining(F) > 0); const int ncv = split ? (l == 0 ? NCONV : 16) : 0;
            if (split && F.bx >= F.G - ncv) converter_slot(F, P, l == 0 ? 5 : 7, 0, F.G - NCH - ncv);
            else if (F.bx >= NCH) {
                const int G2 = F.G - NCH - ncv, c2 = F.bx - NCH;
                OpKv op; op.A = (const bf16_t*)(F.ws + WS_CKV); op.Bt = (const bf16_t*)(F.ws + WS_WUKV) + (size_t)l * 1024 * 256; op.G = G2; op.c = c2;
                op.KF = (bf16_t*)(F.ws + WS_KF); op.MV = (bf16_t*)(F.ws + WS_MV); op.SS = (const float*)(F.ws + WS_SSP);
                op.slab = F.lds + EPI_OFF + F.wave * EPI_SLAB; pg::gemm_phase<OpKv>(F.lds, op, F.wave);
                swa_units(F, P, l, G2, c2, split ? (l == 0 ? 5 : 7) : -1);
            }
        }
        SEAM(pb + 1);
        if (IN(pb + 2)) {
            if (PHEN(7)) { const Frame F = fresh_frame(F0); _Pragma("unroll 1") for (int rep_ = 0; rep_ < NREP(7); ++rep_) { if (rep_) GRID_BAR(); mla_units(F, P, l); } }
            if (PHEN(8)) { const Frame F = fresh_frame(F0);
                const bool split = (F.G == 256) && (l == 0 || conv_remaining(F) > 0); const int ncomp = split ? F.G - NCONV : F.G;
                if (split && F.bx >= ncomp) converter_slot(F, P, l == 0 ? 6 : 8, l == 0 ? 0 : MOE_ITEMS, ncomp);
                else { bool sent = false;
                       for (int u = F.bx; u < NBATCH * 6 * 34; u += ncomp) { if (split && !sent && u + ncomp >= NBATCH * 6 * 34) { conv_signal(F, l == 0 ? 6 : 8); sent = true; }
                           if (l == DEPTH - 1 && (u % 34) < 2) continue; ret::rc_unit(F, P, l, u); }
                       if (split && !sent) conv_signal(F, l == 0 ? 6 : 8);
                       if (split && l == DEPTH - 1) { __syncthreads(); converter_slot(F, P, 8, MOE_ITEMS, ncomp, true); } } }
        }
        SEAM(pb + 2);
        if (IN(pb + 3) && PHEN(9)) {
            const Frame F = fresh_frame(F0);
            const bool split = (l == 0) && (F.G == 256); const int ncomp = split ? F.G - NCONV_OUT : F.G;
            if (split && F.bx >= ncomp) converter_slot(F, P, 1, MOE_ITEMS_L, ncomp);
            else {
                OpOut op; op.A = (const unsigned char*)(F.ws + (MK_OUT8 ? WS_MIX8 : WS_MIX)); op.Bt = (const unsigned char*)(F.ws + WS_WOUT) + (size_t)l * D * D * (MK_OUT8 ? 1 : 2); op.G = ncomp; op.c = F.bx;
                op.Y = (bf16_t*)(F.ws + WS_Y); op.latent_only = (l == DEPTH - 1);
                op.slab = F.lds + EPI_OFF + F.wave * EPI_SLAB; if (split) op.sig = F.ctl + CW_CONV + 64 * (1 + 1); pg::gemm_phase<OpOut>(F.lds, op, F.wave);
                if (split) { __syncthreads(); converter_slot(F, P, 1, MOE_ITEMS_L, ncomp, true); }
            }
        }
        SEAM(pb + 3);
        if (IN(pb + 4) && PHEN(10)) { const Frame F = fresh_frame(F0); if (l == 0) conv_snapshot(F); phase_r4(F, P, l); }
        SEAM(pb + 4);
        if (IN(pb + 5) && PHEN(11)) {
            const Frame F = fresh_frame(F0);
            const bool split = (l == 0) && (F.G == 256) && (conv_remaining(F) > 0); const int ncomp = split ? F.G - NCONV : F.G;
            if (split && F.bx >= ncomp) converter_slot(F, P, 2, MOE_ITEMS_L, ncomp);
            else {
                OpMoe1 op; op.A = (const unsigned char*)(F.ws + WS_H8); op.Bt = (const unsigned char*)(F.ws + WS_WGU) + (size_t)l * NEXP * 2048 * D; op.G = ncomp; op.c = F.bx;
                op.tb = moe_tables(F, l); op.LISTE = (const int*)(F.ws + WS_LISTE); op.ACT = (unsigned char*)(F.ws + WS_ACT);
                if (split) op.sig = F.ctl + CW_CONV + 64 * (1 + 2); pg::gemm_phase<OpMoe1>(F.lds, op, F.wave);
            }
        }
        SEAM(pb + 5);
        if (IN(pb + 6) && PHEN(12)) {
            const Frame F = fresh_frame(F0);
            const bool split = (l == 0) && (F.G == 256) && (conv_remaining(F) > 0); const int ncomp = split ? F.G - NCONV : F.G;
            if (split && F.bx >= ncomp) converter_slot(F, P, 3, MOE_ITEMS_L, ncomp);
            else {
                OpMoe2 op; op.A = (const unsigned char*)(F.ws + WS_ACT); op.Bt = (const unsigned char*)(F.ws + WS_WDN) + (size_t)l * NEXP * D * EH; op.G = ncomp; op.c = F.bx;
                op.tb = moe_tables(F, l); op.LISTE = (const int*)(F.ws + WS_LISTE); op.AW = (const float*)(F.ws + WS_KVI); op.F2 = (unsigned char*)(F.ws + WS_F2);
                if (split) op.sig = F.ctl + CW_CONV + 64 * (1 + 3); pg::gemm_phase<OpMoe2>(F.lds, op, F.wave);
            }
        }
        SEAM(pb + 6);
        if (IN(pb + 7) && PHEN(13)) { const Frame F = fresh_frame(F0); if (l == 0) conv_snapshot(F); phase_r7(F, P, l); }
        SEAM(pb + 7);
    }
#undef IN
#undef SEAM
#undef GRID_BAR
}

extern "C" void kernel_launch(void* const* d_in, const int* in_sizes, int n_in, void* d_out, int out_size, void* d_ws, size_t ws_size, hipStream_t stream) {
    static int grid = 0;
    if (grid == 0) {
        if (n_in != 24 || out_size != NBATCH * SEQ * D || ws_size < WS_END) { fprintf(stderr, "kernel_launch: unexpected shapes: n_in %d out %d ws %zu (need %zu)\n", n_in, out_size, ws_size, (size_t)WS_END); grid = -1; return; }
        int dev = 0, cus = 0, per_cu = 0;
        if (hipGetDevice(&dev) != hipSuccess || hipDeviceGetAttribute(&cus, hipDeviceAttributeMultiprocessorCount, dev) != hipSuccess) { grid = -1; return; }
        if (hipFuncSetAttribute((const void*)hybrid_dit_fwd, hipFuncAttributeMaxDynamicSharedMemorySize, LDS_BYTES) != hipSuccess) { fprintf(stderr, "kernel_launch: hipFuncSetAttribute failed\n"); grid = -1; return; }
        if (hipOccupancyMaxActiveBlocksPerMultiprocessor(&per_cu, (const void*)hybrid_dit_fwd, NTHREADS, LDS_BYTES) != hipSuccess || per_cu < 1)
            fprintf(stderr, "kernel_launch: occupancy query reports %d blocks per CU\n", per_cu);
        (void)hipGetLastError();
        grid = cus < 256 ? cus : 256;
    }
    if (grid < 0) return;
    if (hipMemsetAsync((char*)d_ws + WS_CTL, 0, CTL_BYTES, stream) != hipSuccess) { fprintf(stderr, "kernel_launch: memset failed\n"); return; }
    Params p;
    memset(&p, 0, sizeof(p));
    for (int i = 0; i < 24; ++i) p.in[i] = (const float*)d_in[i];
    p.out = (float*)d_out; p.ws = (unsigned char*)d_ws;
#if MK_PER_PHASE
    for (int k = 0; k < N_PHASES; ++k) { p.ph_lo = k; p.ph_hi = k + 1; hipLaunchKernelGGL(hybrid_dit_fwd, dim3(grid), dim3(NTHREADS), LDS_BYTES, stream, p); }
#else
    p.ph_lo = 0; p.ph_hi = N_PHASES;
    hipLaunchKernelGGL(hybrid_dit_fwd, dim3(grid), dim3(NTHREADS), LDS_BYTES, stream, p);
#endif
    const hipError_t le = hipPeekAtLastError();
    if (le != hipSuccess) fprintf(stderr, "kernel_launch: launch failed: %s\n", hipGetErrorName(le));
}
```
